# Optimizing an MI355X kernel written in HIP

```python
import jax, jax.numpy as jnp
from jax import lax
import numpy as np

D_MODEL = 1024
BATCH = 4
SEQ = 8192
DEPTH = 2

N_META = 16
MIX_WIDTH = D_MODEL
ATTN_WIDTH = MIX_WIDTH // 2
CONV_WIDTH = MIX_WIDTH - ATTN_WIDTH
HEAD_DIM = 64
N_Q_HEADS = ATTN_WIDTH // HEAD_DIM
N_KV_HEADS = 2
GROUP = N_Q_HEADS // N_KV_HEADS
KV_WIDTH = N_KV_HEADS * HEAD_DIM
CONV_GROUPS = 8
CONV_K = 3
WINDOW = 128
BLOCK = 128
LEAD_PAD = BLOCK - N_META
ROPE_THETA = 500000.0
ROT_DIM = HEAD_DIM // 4
D_FF = 4 * D_MODEL
IN_WIDTH = ATTN_WIDTH + 2 * KV_WIDTH + 3 * CONV_WIDTH
EPS = 1e-6

kernel_name = 'hymba_swa_sink_shortconv_sandwich'


def rmsnorm(x, g):
    x32 = x.astype(jnp.float32)
    y = x32 * lax.rsqrt(jnp.mean(x32 * x32, axis=-1, keepdims=True) + EPS)
    return y.astype(x.dtype) * g.astype(x.dtype)


def rope_tables(n_pos):
    pos = jnp.arange(n_pos, dtype=jnp.float32)
    inv_freq = jnp.power(jnp.float32(ROPE_THETA), -jnp.arange(0, ROT_DIM, 2, dtype=jnp.float32) / ROT_DIM)
    ang = pos[:, None] * inv_freq[None, :]
    return jnp.cos(ang), jnp.sin(ang)


def partial_rope(t, cos, sin):
    half = ROT_DIM // 2
    t32 = t[..., :ROT_DIM].astype(jnp.float32)
    t1, t2 = t32[..., :half], t32[..., half:]
    c, s = cos[None, :, None, :], sin[None, :, None, :]
    rot = jnp.concatenate([t1 * c - t2 * s, t2 * c + t1 * s], axis=-1).astype(t.dtype)
    return jnp.concatenate([rot, t[..., ROT_DIM:]], axis=-1)


def sliding_window_gqa_sinks(q, k, v, sink):
    bsz, L = q.shape[0], q.shape[1]
    pad = ((0, 0), (LEAD_PAD, 0), (0, 0), (0, 0))
    q, k, v = jnp.pad(q, pad), jnp.pad(k, pad), jnp.pad(v, pad)
    Lp = L + LEAD_PAD
    nb = Lp // BLOCK
    qb = q.reshape(bsz, nb, BLOCK, N_KV_HEADS, GROUP, HEAD_DIM)

    def band(t):
        tb = t.reshape(bsz, nb, BLOCK, N_KV_HEADS, HEAD_DIM)
        prev = jnp.pad(tb, ((0, 0), (1, 0), (0, 0), (0, 0), (0, 0)))[:, :-1]
        return jnp.concatenate([prev, tb], axis=2)

    kw, vw = band(k), band(v)
    s = jnp.einsum('bnqhgd,bnkhd->bnhgqk', qb, kw,
                   preferred_element_type=jnp.float32) * (HEAD_DIM ** -0.5)
    blk = jnp.arange(nb)[:, None, None]
    qpos = blk * BLOCK + jnp.arange(BLOCK)[None, :, None]
    kpos = (blk - 1) * BLOCK + jnp.arange(2 * BLOCK)[None, None, :]
    mask = (kpos <= qpos) & (qpos - kpos < WINDOW) & (kpos >= LEAD_PAD)
    s = jnp.where(mask[None, :, None, None], s, -jnp.inf)
    sk = sink.astype(jnp.float32).reshape(1, 1, N_KV_HEADS, GROUP, 1, 1)
    m = jnp.maximum(jnp.max(s, axis=-1, keepdims=True), sk)
    e = jnp.exp(s - m)
    p = e / (jnp.sum(e, axis=-1, keepdims=True) + jnp.exp(sk - m))
    o = jnp.einsum('bnhgqk,bnkhd->bnqhgd', p.astype(v.dtype), vw)
    return o.reshape(bsz, Lp, N_Q_HEADS * HEAD_DIM)[:, LEAD_PAD:]


def short_gated_conv(b_gate, c_gate, h, w):
    u = c_gate * h
    y = lax.conv_general_dilated(u, w[:, None, :].astype(u.dtype), window_strides=(1,),
                                 padding=[(CONV_K - 1, 0)],
                                 dimension_numbers=('NWC', 'WIO', 'NWC'),
                                 feature_group_count=CONV_WIDTH)
    return b_gate * y


def setup_inputs(seed: int = 0) -> dict:
    key = jax.random.key(seed)
    ks = jax.random.split(key, 16)
    f32 = jnp.float32

    def nrm(k, shape, scale):
        return jax.random.normal(k, shape, f32) * scale

    def gain(k, shape):
        return 1.0 + 0.05 * jax.random.normal(k, shape, f32)

    return {
        'x': nrm(ks[0], (BATCH, SEQ, D_MODEL), 1.0),
        'meta_tokens': nrm(ks[1], (N_META, D_MODEL), 1.0),
        'mix_pre_g': gain(ks[2], (DEPTH, D_MODEL)),
        'w_in': nrm(ks[3], (DEPTH, D_MODEL, IN_WIDTH), D_MODEL ** -0.5),
        'conv_w': nrm(ks[4], (DEPTH, CONV_K, CONV_WIDTH), CONV_K ** -0.5),
        'sinks': nrm(ks[5], (DEPTH, N_Q_HEADS), 0.5),
        'attn_out_g': gain(ks[6], (DEPTH, ATTN_WIDTH)),
        'conv_out_g': gain(ks[7], (DEPTH, CONV_WIDTH)),
        'w_out': nrm(ks[8], (DEPTH, MIX_WIDTH, D_MODEL), MIX_WIDTH ** -0.5),
        'mix_post_g': gain(ks[9], (DEPTH, D_MODEL)),
        'mlp_pre_g': gain(ks[10], (DEPTH, D_MODEL)),
        'w_up': nrm(ks[11], (DEPTH, D_MODEL, D_FF), D_MODEL ** -0.5),
        'w_down': nrm(ks[12], (DEPTH, D_FF, D_MODEL), D_FF ** -0.5),
        'mlp_post_g': gain(ks[13], (DEPTH, D_MODEL)),
    }


def reference(x, meta_tokens, mix_pre_g, w_in, conv_w, sinks, attn_out_g, conv_out_g,
              w_out, mix_post_g, mlp_pre_g, w_up, w_down, mlp_post_g):
    bsz = x.shape[0]
    meta = jnp.broadcast_to(meta_tokens[None].astype(x.dtype), (bsz, N_META, D_MODEL))
    h = jnp.concatenate([meta, x], axis=1)
    L = h.shape[1]
    cos, sin = rope_tables(L)
    s_q = ATTN_WIDTH
    s_k = s_q + KV_WIDTH
    s_v = s_k + KV_WIDTH
    s_b = s_v + CONV_WIDTH
    s_c = s_b + CONV_WIDTH
    for l in range(DEPTH):
        a = rmsnorm(h, mix_pre_g[l])
        proj = a @ w_in[l]
        q = proj[..., :s_q].reshape(bsz, L, N_Q_HEADS, HEAD_DIM)
        k = proj[..., s_q:s_k].reshape(bsz, L, N_KV_HEADS, HEAD_DIM)
        v = proj[..., s_k:s_v].reshape(bsz, L, N_KV_HEADS, HEAD_DIM)
        b_gate = proj[..., s_v:s_b]
        c_gate = proj[..., s_b:s_c]
        hc = proj[..., s_c:]
        q = partial_rope(q, cos, sin)
        k = partial_rope(k, cos, sin)
        y_attn = sliding_window_gqa_sinks(q, k, v, sinks[l])
        y_conv = short_gated_conv(b_gate, c_gate, hc, conv_w[l])
        y = jnp.concatenate([rmsnorm(y_attn, attn_out_g[l]),
                             rmsnorm(y_conv, conv_out_g[l])], axis=-1)
        h = h + rmsnorm(y @ w_out[l], mix_post_g[l])
        a = rmsnorm(h, mlp_pre_g[l])
        f = jnp.square(jax.nn.relu(a @ w_up[l])) @ w_down[l]
        h = h + rmsnorm(f, mlp_post_g[l])
    return h[:, N_META:]
```

```cpp
#include <hip/hip_runtime.h>
#include <hip/hip_cooperative_groups.h>
#include <cstdio>
#include <cstdint>
#include <cmath>
namespace cg = cooperative_groups;
__device__ __forceinline__ int fresh_tid(int wave) { int l; asm volatile("v_mbcnt_lo_u32_b32 %0, -1, 0\n\tv_mbcnt_hi_u32_b32 %0, -1, %0" : "=v"(l)); return wave * 64 + l; }
namespace pg8 {
#define PG8_LAS __attribute__((address_space(3)))
typedef unsigned short bf16_t;
typedef short bf16x8 __attribute__((ext_vector_type(8)));
typedef float f32x4 __attribute__((ext_vector_type(4)));
typedef unsigned u32x4 __attribute__((ext_vector_type(4)));
constexpr int BM = 256, BK = 64, HALF = 128, HTB = HALF * BK * 2  , STAGE_BYTES = 8 * HTB, NXCD = 8, WGM = 8;

__host__ __device__ __forceinline__ int lds_byte(int r, int c) { const int st = (r >> 4) * 2 + (c >> 5), rr = r & 15, cc = c & 31, ob = rr * 64 + cc * 2; return st * 1024 + (ob ^ (((ob >> 9) & 1) << 5)); }
__host__ __device__ __forceinline__ void stage_rc(int b, int& R, int& C) { const int st = b / 1024, sb = b % 1024, swz = sb ^ (((sb >> 9) & 1) << 5); R = (st >> 1) * 16 + swz / 64; C = (st & 1) * 32 + (swz % 64) / 2; }
__host__ __device__ __forceinline__ int perm32(int rho) { const int n = rho >> 4, i = rho & 15; return 8 * (i >> 2) + 4 * n + (i & 3); }

struct Unit { int pm, pn; };
struct Gemm { const bf16_t* A; const bf16_t* Bt; int M, N, K; };

struct StaticOrder {
    int nM, nN, nwg, G, c, wgm;
    __host__ __device__ void init(int M, int N, int G_, int c_, int wgm_ = WGM) { nM = M / BM; nN = N / BM; nwg = nM * nN; G = G_; c = c_; wgm = wgm_; }
    __host__ __device__ bool next(int i, Unit& u) const {
        const long L = (long)i * G + c; if (L >= nwg) return false;
        int wgid = (int)L; { const int q = nwg / NXCD, r = nwg % NXCD, xcd = wgid % NXCD, off = wgid / NXCD; wgid = (xcd < r ? xcd * (q + 1) : r * (q + 1) + (xcd - r) * q) + off; }
        const int nig = wgm * nN, gid = wgid / nig, fm = gid * wgm, gsz = (nM - fm) < wgm ? (nM - fm) : wgm;
        u.pm = fm + ((wgid % nig) % gsz); u.pn = (wgid % nig) / gsz; return true;
    }
    __device__ __forceinline__ void a_ready(const Unit&) const {}
    __device__ __forceinline__ void done(const Unit&) const {}
};
__device__ __forceinline__ unsigned cvt_pk_bf16(float lo, float hi) { unsigned r; asm volatile("v_cvt_pk_bf16_f32 %0, %1, %2" : "=v"(r) : "v"(lo), "v"(hi)); return r; }
template <class Epi, class Sched, bool ALIGN_EPI = false, bool SP2 = false, bool ATILED = false>
__device__ __forceinline__ void gemm_phase(PG8_LAS unsigned char* lds, const Gemm g, const Sched& S, const Epi& E, const int wave_id) {
    const int tid = fresh_tid(wave_id);
    const int wid = wave_id, lane = tid & 63, wr = wid >> 2, wc = wid & 3, fr = lane & 15, fq = lane >> 4;
    const int K = g.K, nt = K / BK;
    unsigned voffA[2], voffB[2];
#pragma unroll
    for (int i = 0; i < 2; ++i) { int R, C; stage_rc(tid * 16 + i * 8192, R, C); const int Rb = Epi::PERM ? ((R & ~31) + perm32(R & 31)) : R;
        voffA[i] = (unsigned)(R * (ATILED ? 256 : K) + C) * 2u; voffB[i] = (unsigned)(Rb * K + C) * 2u; }
    const size_t kstep = (size_t)(BK * 2);
    const size_t hstep = (size_t)HALF * K * 2, hstepA = ATILED ? (size_t)HALF * 256 * 2 : hstep;
    const size_t tstep = 2 * hstep;
    const unsigned ldsw = (unsigned)wid * 1024u;
    const int aoff = lds_byte(wr * 64 + fr, fq * 8), boff = lds_byte(wc * 32 + fr, fq * 8);
#define PG8_SA(b, h) (((b) * 2 + (h)) * HTB)
#define PG8_SB(b, h) ((4 + (b) * 2 + (h)) * HTB)
#define PG8_STAGE(bufoff, gbase, voff) do { _Pragma("unroll") for (int _i = 0; _i < 2; ++_i) \
        __builtin_amdgcn_global_load_lds((const unsigned*)((const char*)(gbase) + (voff)[_i]), (PG8_LAS unsigned*)(lds + (bufoff) + ldsw + _i * 8192), 16, 0, 0); } while (0)
#define PG8_LDA(dst, b, h) do { _Pragma("unroll") for (int m = 0; m < 4; ++m) _Pragma("unroll") for (int k = 0; k < 2; ++k) dst[m][k] = *(const PG8_LAS bf16x8*)(lds + PG8_SA(b, h) + aoff + m * 2048 + k * 1024); } while (0)
#define PG8_LDB(dst, b, h) do { _Pragma("unroll") for (int n = 0; n < 2; ++n) _Pragma("unroll") for (int k = 0; k < 2; ++k) dst[n][k] = *(const PG8_LAS bf16x8*)(lds + PG8_SB(b, h) + boff + n * 2048 + k * 1024); } while (0)
#define PG8_MMA(ai, bj, At, Bt) do { __builtin_amdgcn_s_setprio(1); _Pragma("unroll") for (int m = 0; m < 4; ++m) _Pragma("unroll") for (int n = 0; n < 2; ++n) _Pragma("unroll") for (int k = 0; k < 2; ++k) \
        acc[ai][bj][m][n] = __builtin_amdgcn_mfma_f32_16x16x32_bf16(Bt[n][k], At[m][k], acc[ai][bj][m][n], 0, 0, 0); __builtin_amdgcn_s_setprio(0); } while (0)
#define PG8_WAIT_V(n) asm volatile("s_waitcnt vmcnt(" #n ")" ::: "memory")
#define PG8_WAIT_L(n) asm volatile("s_waitcnt lgkmcnt(" #n ")" ::: "memory")
#define PG8_BAR __builtin_amdgcn_s_barrier()
#define PG8_SCHED __builtin_amdgcn_sched_barrier(0)
    Unit cur, nxt; int ui = 0;
    if (!S.next(0, cur)) return;
    f32x4 acc[2][2][4][2];
#pragma unroll
    for (int a = 0; a < 2; ++a)
#pragma unroll
        for (int b = 0; b < 2; ++b)
#pragma unroll
            for (int m = 0; m < 4; ++m)
#pragma unroll
                for (int n = 0; n < 2; ++n) acc[a][b][m][n] = (f32x4){0.f, 0.f, 0.f, 0.f};
    bf16x8 At[4][2], B0[2][2], B1[2][2];
    const char* cA = (const char*)g.A + (size_t)cur.pm * tstep; const char* cB = (const char*)g.Bt + (size_t)cur.pn * tstep;
    S.a_ready(cur);
    if constexpr (SP2) {
        PG8_STAGE(PG8_SB(0, 0), cB, voffB); PG8_STAGE(PG8_SB(0, 1), cB + hstep, voffB); PG8_STAGE(PG8_SA(0, 0), cA, voffA); PG8_STAGE(PG8_SA(0, 1), cA + hstepA, voffA);
        if (wr == 1) PG8_BAR;
        PG8_WAIT_V(2); PG8_BAR;
        PG8_STAGE(PG8_SB(1, 0), cB + kstep, voffB); PG8_STAGE(PG8_SA(1, 0), cA + kstep, voffA); PG8_STAGE(PG8_SB(1, 1), cB + hstep + kstep, voffB);
        PG8_WAIT_V(6); PG8_BAR;
    } else {
        PG8_STAGE(PG8_SB(0, 0), cB, voffB); PG8_STAGE(PG8_SA(0, 0), cA, voffA); PG8_STAGE(PG8_SB(0, 1), cB + hstep, voffB); PG8_STAGE(PG8_SA(0, 1), cA + hstepA, voffA);
        if (wr == 1) PG8_BAR;
        PG8_WAIT_V(4); PG8_BAR;
        PG8_STAGE(PG8_SB(1, 0), cB + kstep, voffB); PG8_STAGE(PG8_SA(1, 0), cA + kstep, voffA); PG8_STAGE(PG8_SB(1, 1), cB + hstep + kstep, voffB);
        PG8_WAIT_V(6); PG8_BAR;
    }
    for (;;) {
        const bool has_next = S.next(ui + 1, nxt);
        const char* nA = has_next ? (const char*)g.A + (size_t)nxt.pm * tstep : cA; const char* nB = has_next ? (const char*)g.Bt + (size_t)nxt.pn * tstep : cB;
        for (int t = 0; t < nt; t += 2) {
            const bool last = (t == nt - 2);
            const char* a1 = cA + (ATILED ? (size_t)((t + 1) >> 2) * 131072 + (size_t)((t + 1) & 3) * kstep : (size_t)(t + 1) * kstep);
            const char* a2 = last ? nA : cA + (ATILED ? (size_t)((t + 2) >> 2) * 131072 + (size_t)((t + 2) & 3) * kstep : (size_t)(t + 2) * kstep); const char* b2 = last ? nB : cB + (size_t)(t + 2) * kstep;
            const char* a3 = a2 + kstep; const char* b3 = b2 + kstep;
            if (last && has_next) S.a_ready(nxt);
            if constexpr (SP2) {
            PG8_LDB(B0, 0, 0); PG8_LDB(B1, 0, 1); PG8_SCHED; PG8_LDA(At, 0, 0); PG8_STAGE(PG8_SA(1, 1), a1 + hstepA, voffA);
            PG8_WAIT_V(8); PG8_WAIT_L(0); PG8_BAR; PG8_MMA(0, 0, At, B0); PG8_MMA(0, 1, At, B1); PG8_BAR; PG8_SCHED;
            PG8_LDA(At, 0, 1); PG8_STAGE(PG8_SB(0, 0), b2, voffB); PG8_STAGE(PG8_SB(0, 1), b2 + hstep, voffB); PG8_STAGE(PG8_SA(0, 0), a2, voffA);
            PG8_WAIT_V(8); PG8_WAIT_L(0); PG8_BAR; PG8_MMA(1, 0, At, B0); PG8_MMA(1, 1, At, B1); PG8_BAR; PG8_SCHED;
            PG8_LDB(B0, 1, 0); PG8_LDB(B1, 1, 1); PG8_SCHED; PG8_LDA(At, 1, 0); PG8_STAGE(PG8_SA(0, 1), a2 + hstepA, voffA);
            PG8_WAIT_V(8); PG8_WAIT_L(0); PG8_BAR; PG8_MMA(0, 0, At, B0); PG8_MMA(0, 1, At, B1); PG8_BAR; PG8_SCHED;
            PG8_LDA(At, 1, 1); PG8_STAGE(PG8_SB(1, 0), b3, voffB); PG8_STAGE(PG8_SB(1, 1), b3 + hstep, voffB); PG8_STAGE(PG8_SA(1, 0), a3, voffA);
            PG8_WAIT_V(8); PG8_WAIT_L(0); PG8_BAR; PG8_MMA(1, 0, At, B0); PG8_MMA(1, 1, At, B1); PG8_BAR; PG8_SCHED;
            } else {
            PG8_LDB(B0, 0, 0); PG8_SCHED; PG8_LDA(At, 0, 0); PG8_STAGE(PG8_SA(1, 1), a1 + hstepA, voffA);
            PG8_WAIT_L(8); PG8_BAR; PG8_WAIT_L(0); PG8_MMA(0, 0, At, B0); PG8_BAR; PG8_SCHED;
            PG8_LDB(B1, 0, 1); PG8_STAGE(PG8_SB(0, 0), b2, voffB);
            PG8_BAR; PG8_WAIT_L(0); PG8_MMA(0, 1, At, B1); PG8_BAR;
            PG8_LDA(At, 0, 1); PG8_STAGE(PG8_SA(0, 0), a2, voffA);
            PG8_BAR; PG8_WAIT_L(0); PG8_MMA(1, 0, At, B0); PG8_BAR; PG8_SCHED;
            PG8_STAGE(PG8_SB(0, 1), b2 + hstep, voffB);
            PG8_WAIT_V(6); PG8_BAR; PG8_MMA(1, 1, At, B1); PG8_BAR;
            PG8_LDB(B0, 1, 0); PG8_SCHED; PG8_LDA(At, 1, 0); PG8_STAGE(PG8_SA(0, 1), a2 + hstepA, voffA);
            PG8_WAIT_L(8); PG8_BAR; PG8_WAIT_L(0); PG8_MMA(0, 0, At, B0); PG8_BAR; PG8_SCHED;
            PG8_LDB(B1, 1, 1); PG8_STAGE(PG8_SB(1, 0), b3, voffB);
            PG8_BAR; PG8_WAIT_L(0); PG8_MMA(0, 1, At, B1); PG8_BAR;
            PG8_LDA(At, 1, 1); PG8_STAGE(PG8_SA(1, 0), a3, voffA);
            PG8_BAR; PG8_WAIT_L(0); PG8_MMA(1, 0, At, B0); PG8_BAR; PG8_SCHED;
            PG8_STAGE(PG8_SB(1, 1), b3 + hstep, voffB);
            PG8_WAIT_V(6); PG8_BAR; PG8_MMA(1, 1, At, B1); PG8_BAR;
            }
        }
        if constexpr (ALIGN_EPI) { if (wr == 0) PG8_BAR; }
        if constexpr (!Epi::AFTER_DRAIN) { E(acc, cur, wr, wc, fr, fq); S.done(cur); }
        if (!has_next) break;
#pragma unroll
        for (int a = 0; a < 2; ++a)
#pragma unroll
            for (int b = 0; b < 2; ++b)
#pragma unroll
                for (int m = 0; m < 4; ++m)
#pragma unroll
                    for (int n = 0; n < 2; ++n) acc[a][b][m][n] = (f32x4){0.f, 0.f, 0.f, 0.f};
        cur = nxt; cA = nA; cB = nB; ++ui;
        if constexpr (ALIGN_EPI) { if (wr == 1) PG8_BAR; }
    }
    PG8_WAIT_V(0);
    if constexpr (!ALIGN_EPI) { if (wr == 0) PG8_BAR; }
    PG8_BAR;
    if constexpr (Epi::AFTER_DRAIN) { E.fused(acc, cur, wr, wc, fr, fq, lds, wid, lane); S.done(cur); }
#undef PG8_SA
#undef PG8_SB
#undef PG8_STAGE
#undef PG8_LDA
#undef PG8_LDB
#undef PG8_MMA
#undef PG8_WAIT_V
#undef PG8_WAIT_L
#undef PG8_BAR
#undef PG8_SCHED
}
}
#define GAS __attribute__((address_space(1)))
#define LAS __attribute__((address_space(3)))
typedef unsigned short bf16;
typedef unsigned u32x4 __attribute__((ext_vector_type(4)));
typedef unsigned u32x2 __attribute__((ext_vector_type(2)));
typedef float f32x4 __attribute__((ext_vector_type(4)));
typedef float f32x2 __attribute__((ext_vector_type(2)));
typedef float f32x16 __attribute__((ext_vector_type(16)));
typedef short bf16x8 __attribute__((ext_vector_type(8)));
typedef __bf16 bf16v2 __attribute__((ext_vector_type(2)));
#define LDS_WAIT() asm volatile("s_waitcnt lgkmcnt(0)" ::: "memory")
__device__ __forceinline__ unsigned pk2(float lo, float hi) { return __builtin_bit_cast(unsigned, __builtin_convertvector((f32x2){lo, hi}, bf16v2)); }
__device__ __forceinline__ float bflo(unsigned w) { return __builtin_bit_cast(float, w << 16); }
__device__ __forceinline__ float bfhi(unsigned w) { return __builtin_bit_cast(float, w & 0xffff0000u); }
__device__ __forceinline__ float wave_sum(float v) {
#pragma unroll
    for (int o = 1; o < 64; o <<= 1) v += __shfl_xor(v, o);
    return v;
}
#define XB_TMO      128
#define XB_XCNT(j)  (256  + 64 * (j))
#define XB_XSUB(j)  (1280 + 64 * (j))
#define XB_XGEN(j)  (2304 + 64 * (j))
#define XB_TOP      3328
#define XB_TOPGEN   3392
#define XCD_BAR_WORDS 3456
#define XB_SPIN_CAP (1u << 18)

__device__ __forceinline__ unsigned xb_ld(unsigned* p)              { return __hip_atomic_load(p, __ATOMIC_RELAXED, __HIP_MEMORY_SCOPE_AGENT); }
__device__ __forceinline__ unsigned xb_add(unsigned* p, unsigned v) { return __hip_atomic_fetch_add(p, v, __ATOMIC_RELAXED, __HIP_MEMORY_SCOPE_AGENT); }
__device__ __forceinline__ unsigned xb_xcc_id() { return (unsigned)__builtin_amdgcn_s_getreg((3 << 11) | 20) & 0xFu; }
#define XB_SPIN(cond, bar) do { unsigned _sp = 0; while (cond) { __builtin_amdgcn_s_sleep(1); \
    if ((++_sp & 255u) == 0u) { if (xb_ld(&(bar)[XB_TMO])) break; if (_sp > XB_SPIN_CAP) { atomicAdd(&(bar)[XB_TMO], 1u); break; } } } } while (0)

struct XcdBarrier {
    unsigned* bar; unsigned x; int w;
    volatile LAS unsigned* st;
};

__device__ __forceinline__ XcdBarrier xcd_barrier_post(unsigned* bar, volatile LAS unsigned* st, int wave) {
    XcdBarrier b; b.bar = bar; b.x = xb_xcc_id(); b.st = st; b.w = wave;
    if (fresh_tid(wave) == 0) (void)xb_add(&bar[XB_XCNT(b.x)], 1u);
    return b;
}
__device__ __forceinline__ void xcd_barrier_complete(unsigned* bar, unsigned x, unsigned& nloc, unsigned& nx) {
    const unsigned G = gridDim.x * gridDim.y * gridDim.z;
    unsigned sum, cnt, mine, sp = 0u;
    for (;;) {
        sum = 0u; cnt = 0u; mine = 0u;
#pragma unroll
        for (unsigned j = 0; j < 16; ++j) { const unsigned c = xb_ld(&bar[XB_XCNT(j)]); sum += c; cnt += (c > 0u) ? 1u : 0u; mine = (j == x) ? c : mine; }
        if (sum == G) break;
        __builtin_amdgcn_s_sleep(1);
        if ((++sp & 255u) == 0u) { if (xb_ld(&bar[XB_TMO])) break; if (sp > XB_SPIN_CAP) { atomicAdd(&bar[XB_TMO], 1u); break; } }
    }
    nloc = mine > 0u ? mine : 1u; nx = cnt > 0u ? cnt : 1u;
}

__device__ __forceinline__ void xcd_barrier(const XcdBarrier& b) {
    asm volatile("s_waitcnt vmcnt(0)" ::: "memory");
    __syncthreads();
    if (fresh_tid(b.w) == 0) {
        unsigned* bar = b.bar;
        __builtin_amdgcn_s_waitcnt(0);
        unsigned nloc = b.st[0], nx = b.st[1];
        if (nloc == 0u) { xcd_barrier_complete(bar, b.x, nloc, nx); b.st[0] = nloc; b.st[1] = nx; }
        const unsigned old = xb_add(&bar[XB_XSUB(b.x)], 1u);
        const unsigned gen = old / nloc;
        if (old + 1u == (gen + 1u) * nloc) {
            __builtin_amdgcn_fence(__ATOMIC_RELEASE, "agent");
            asm volatile("s_waitcnt vmcnt(0)" ::: "memory");
            (void)xb_add(&bar[XB_TOP], 1u);
        }
        XB_SPIN(xb_ld(&bar[XB_TOP]) < (gen + 1u) * nx, bar);
        __builtin_amdgcn_fence(__ATOMIC_ACQUIRE, "agent");
        asm volatile("s_waitcnt vmcnt(0)" ::: "memory");
    }
    __syncthreads();
}

constexpr int D = 1024, SEQ = 8192, NBATCH = 4, NMETA = 16;
constexpr int M_MAIN = NBATCH * SEQ;
constexpr int META0 = M_MAIN;
constexpr int M_REAL = M_MAIN + NMETA;
constexpr int M_PAD = M_MAIN + 256;
constexpr int INW = 2304, FF = 4096;
constexpr int C_K = 512, C_V = 640, C_B = 768, C_C = 1280, C_H = 1792;
constexpr int PW = 1792, C_U = 1280;
constexpr int LPOS = SEQ + NMETA;
constexpr float EPS = 1e-6f;
constexpr float LOG2E = 1.4426950408889634f;
constexpr float QSCALE = 0.125f * LOG2E;
constexpr int NWAVES = 8, NTHREADS = 512;

constexpr size_t MiB = 1u << 20;
constexpr size_t WS_CTL = 0, CTL_BYTES = 256 * 1024;
constexpr size_t WS_ROPE = 1 * MiB;
constexpr size_t WS_PART = 3 * MiB;
constexpr size_t WS_W = 6 * MiB;
constexpr size_t W_IN_B = (size_t)INW * D * 2, W_OUT_B = (size_t)D * D * 2, W_UP_B = (size_t)FF * D * 2, W_DN_B = (size_t)D * FF * 2;
constexpr size_t W_LAYER = W_IN_B + W_OUT_B + W_UP_B + W_DN_B;
constexpr size_t ROWB = (size_t)M_PAD * 2;
constexpr size_t WS_HB = WS_W + 2 * W_LAYER;
constexpr size_t WS_Z = WS_HB + ROWB * D;
constexpr size_t WS_U = WS_Z + ROWB * D;
constexpr size_t WS_PROJ = WS_U;
constexpr size_t WS_Y = WS_PROJ + ROWB * PW;
constexpr size_t WS_END = WS_U + ROWB * FF;
static_assert(WS_Y + ROWB * D <= WS_END, "Y inside U's overlay");
constexpr int CW_BAR = 1024;
constexpr int CW_T = 12288;
constexpr int CW_X = 16384;
constexpr size_t WS_X = WS_Z;
constexpr size_t WS_PARTB = WS_Z + 4 * MiB;
constexpr int XL_OFF = 131072;
constexpr int CW_META = 8192;

constexpr int KL_OFF = 0, KL_ROW = 72;
constexpr int VT_OFF = 2 * 256 * KL_ROW * 2, VT_ROW = 260;
constexpr int SS_OFF = VT_OFF + 2 * 64 * VT_ROW * 2;
constexpr int MISC_OFF = SS_OFF + 8 * 128 * 4;
constexpr int LDS_BYTES = 147456;
static_assert(MISC_OFF + 128 <= LDS_BYTES && MISC_OFF >= 131072, "LDS map");

struct Params {
    const float *x, *meta, *mix_pre_g, *w_in, *conv_w, *sinks, *attn_out_g, *conv_out_g, *w_out, *mix_post_g, *mlp_pre_g, *w_up, *w_down, *mlp_post_g;
    float* out; unsigned char* ws;
    float inv_freq[8];
};

__host__ __device__ __forceinline__ int ch_ucol(int t  ) { const int w = t & 255; return 128 * (t >> 8) + 8 * (4 * ((w >> 5) & 3) + ((w >> 3) & 3)) + 4 * (w >> 7) + (w & 3); }
__device__ __forceinline__ float row_scale_of(const f32x4 t) {
    float s = (t[0] + t[1]) + (t[2] + t[3]);
    s += __shfl_xor(s, 16); s += __shfl_xor(s, 32);
    return rsqrtf(s * (1.f / D) + EPS);
}
__device__ __forceinline__ float row_scale(const float* part, int row, int fq) {
    const f32x4 t = *(const f32x4*)(part + (size_t)row * 16 + 4 * fq);
    float s = (t[0] + t[1]) + (t[2] + t[3]);
    s += __shfl_xor(s, 16); s += __shfl_xor(s, 32);
    return rsqrtf(s * (1.f / D) + EPS);
}
__device__ __forceinline__ void rope_step16(f32x4 (&cs)[4]) {
    { const float c = cs[0][0], s = cs[0][1]; cs[0][0] = c * -9.576594830e-01f - s * -2.879033089e-01f; cs[0][1] = s * -9.576594830e-01f + c * -2.879033089e-01f; }
    { const float c = cs[0][2], s = cs[0][3]; cs[0][2] = c * -9.992462397e-01f - s * 3.881900758e-02f; cs[0][3] = s * -9.992462397e-01f + c * 3.881900758e-02f; }
    { const float c = cs[1][0], s = cs[1][1]; cs[1][0] = c * 8.243765235e-01f - s * 5.660418272e-01f; cs[1][1] = s * 8.243765235e-01f + c * 5.660418272e-01f; }
    { const float c = cs[1][2], s = cs[1][3]; cs[1][2] = c * 9.932003021e-01f - s * 1.164180413e-01f; cs[1][3] = s * 9.932003021e-01f + c * 1.164180413e-01f; }
    { const float c = cs[2][0], s = cs[2][1]; cs[2][0] = c * 9.997439981e-01f - s * 2.262548544e-02f; cs[2][1] = s * 9.997439981e-01f + c * 2.262548544e-02f; }
    { const float c = cs[2][2], s = cs[2][3]; cs[2][2] = c * 9.999903440e-01f - s * 4.387957044e-03f; cs[2][3] = s * 9.999903440e-01f + c * 4.387957044e-03f; }
    { const float c = cs[3][0], s = cs[3][1]; cs[3][0] = c * 9.999996424e-01f - s * 8.509272011e-04f; cs[3][1] = s * 9.999996424e-01f + c * 8.509272011e-04f; }
    { const float c = cs[3][2], s = cs[3][3]; cs[3][2] = c * 1.000000000e+00f - s * 1.650141639e-04f; cs[3][3] = s * 1.000000000e+00f + c * 1.650141639e-04f; }
}
__device__ __forceinline__ void rope_step80(f32x4 (&cs)[4]) {
    { const float c = cs[0][0], s = cs[0][1]; cs[0][0] = c * -1.103872433e-01f - s * -9.938886762e-01f; cs[0][1] = s * -1.103872433e-01f + c * -9.938886762e-01f; }
    { const float c = cs[0][2], s = cs[0][3]; cs[0][2] = c * -9.812132120e-01f - s * 1.929264963e-01f; cs[0][3] = s * -9.812132120e-01f + c * 1.929264963e-01f; }
    { const float c = cs[1][0], s = cs[1][1]; cs[1][0] = c * -9.911538959e-01f - s * 1.327174604e-01f; cs[1][1] = s * -9.911538959e-01f + c * 1.327174604e-01f; }
    { const float c = cs[1][2], s = cs[1][3]; cs[1][2] = c * 8.345872760e-01f - s * 5.508757234e-01f; cs[1][3] = s * 8.345872760e-01f + c * 5.508757234e-01f; }
    { const float c = cs[2][0], s = cs[2][1]; cs[2][0] = c * 9.936068058e-01f - s * 1.128958836e-01f; cs[2][1] = s * 9.936068058e-01f + c * 1.128958836e-01f; }
    { const float c = cs[2][2], s = cs[2][3]; cs[2][2] = c * 9.997593164e-01f - s * 2.193809487e-02f; cs[2][3] = s * 9.997593164e-01f + c * 2.193809487e-02f; }
    { const float c = cs[3][0], s = cs[3][1]; cs[3][0] = c * 9.999909401e-01f - s * 4.254623782e-03f; cs[3][1] = s * 9.999909401e-01f + c * 4.254623782e-03f; }
    { const float c = cs[3][2], s = cs[3][3]; cs[3][2] = c * 9.999996424e-01f - s * 8.250707178e-04f; cs[3][3] = s * 9.999996424e-01f + c * 8.250707178e-04f; }
}
struct EpiIn {
    static constexpr bool PERM = true, AFTER_DRAIN = false;
    bf16* O; const float* part; const float* rope;
    __device__ __forceinline__ void operator()(const pg8::f32x4 (&acc)[2][2][4][2], const pg8::Unit& u, int wr, int wc, int fr, int fq) const {
        const int row0 = u.pm * 256 + wr * 64 + fr, colt = u.pn * 256;
        const bool ropewave = (u.pn <= 2) && ((wc & 1) == 0);
        const float sgn = (fq == 0) ? -1.f : 1.f;
        float scv[2][4]; f32x4 ptv[2][4];
        f32x4 cs[4];
        if (ropewave) { const f32x4* rp = (const f32x4*)(rope + (size_t)((row0 & (SEQ - 1)) + NMETA) * 16);
#pragma unroll
            for (int i = 0; i < 4; ++i) cs[i] = rp[i]; }
#pragma unroll
        for (int ai = 0; ai < 2; ++ai)
#pragma unroll
            for (int m = 0; m < 4; ++m) ptv[ai][m] = *(const f32x4*)(part + (size_t)(row0 + ai * 128 + m * 16) * 16 + 4 * fq);
#pragma unroll
        for (int ai = 0; ai < 2; ++ai)
#pragma unroll
            for (int m = 0; m < 4; ++m) scv[ai][m] = row_scale_of(ptv[ai][m]);
#pragma unroll
        for (int gp = 0; gp < 4; ++gp) {
            const int ai = gp >> 1;
#pragma unroll
            for (int mm = 0; mm < 2; ++mm) {
                const int m = 2 * (gp & 1) + mm;
                const int row = row0 + ai * 128 + m * 16;
                const float sc = scv[ai][m];
                if (ropewave && (gp | mm) != 0) { if (m == 0) rope_step80(cs); else rope_step16(cs); }
                bf16* rowp = O + (size_t)row * PW + colt + wc * 32 + 8 * fq;
                if (u.pn >= 5) {
                    const f32x4 u0 = (acc[ai][0][m][0] * sc) * (acc[ai][0][m][1] * sc), u1 = (acc[ai][1][m][0] * sc) * (acc[ai][1][m][1] * sc);
                    u32x4 w; w.x = pk2(u0[0], u0[1]); w.y = pk2(u0[2], u0[3]); w.z = pk2(u1[0], u1[1]); w.w = pk2(u1[2], u1[3]);
                    *(u32x4*)(O + (size_t)row * PW + C_U + 128 * (u.pn - 5) + 8 * (4 * wc + fq)) = w;
                    continue;
                }
#pragma unroll
                for (int bj = 0; bj < 2; ++bj) {
                    f32x4 v0 = acc[ai][bj][m][0] * sc, v1 = acc[ai][bj][m][1] * sc;
                    if (ropewave && (u.pn < 2 || bj == 0)) {
                        f32x4 p0, p1;
#pragma unroll
                        for (int e = 0; e < 4; ++e) { p0[e] = __shfl_xor(v0[e], 16); p1[e] = __shfl_xor(v1[e], 16); }
                        if (fq < 2) {
#pragma unroll
                            for (int e = 0; e < 4; ++e) {
                                const float c0 = cs[e >> 1][(e & 1) * 2], s0 = cs[e >> 1][(e & 1) * 2 + 1];
                                const float c1 = cs[2 + (e >> 1)][(e & 1) * 2], s1 = cs[2 + (e >> 1)][(e & 1) * 2 + 1];
                                v0[e] = v0[e] * c0 + sgn * p0[e] * s0;
                                v1[e] = v1[e] * c1 + sgn * p1[e] * s1;
                            }
                        }
                    }
                    if (u.pn < 2) { v0 = v0 * QSCALE; v1 = v1 * QSCALE; }
                    u32x4 w; w.x = pk2(v0[0], v0[1]); w.y = pk2(v0[2], v0[3]); w.z = pk2(v1[0], v1[1]); w.w = pk2(v1[2], v1[3]);
                    *(u32x4*)(rowp + bj * 128) = w;
                }
            }
        }
    }
};
template <bool FINAL> struct EpiRes {
    static constexpr bool PERM = true, AFTER_DRAIN = false;
    bf16* HB; float* OUT; const float* g; float* PART; float* X; unsigned* cnt; LAS unsigned char* lds;
    const float* psc;
    __device__ __forceinline__ void operator()(const pg8::f32x4 (&acc)[2][2][4][2], const pg8::Unit& u, int wr, int wc, int fr, int fq) const {
        LAS float* Pt = (LAS float*)(lds + XL_OFF); LAS float* St = Pt + 1024;
        const int tid = (wr * 4 + wc) * 64 + fq * 16 + fr;
        const int colw = u.pn * 256 + wc * 32 + 8 * fq;
        bf16* hbase = HB + (size_t)(u.pm * 256 + wr * 64 + fr) * D + colw;
        u32x4 hq0[4][2];
#pragma unroll
        for (int m = 0; m < 4; ++m)
#pragma unroll
            for (int bj = 0; bj < 2; ++bj) hq0[m][bj] = *(const u32x4*)(hbase + (size_t)(m * 16) * D + bj * 128);
#pragma unroll
        for (int ai = 0; ai < 2; ++ai)
#pragma unroll
            for (int m = 0; m < 4; ++m) {
                float ss = 0.f;
#pragma unroll
                for (int bj = 0; bj < 2; ++bj) { const f32x4 v0 = acc[ai][bj][m][0], v1 = acc[ai][bj][m][1];
                    ss += (v0[0] * v0[0] + v0[1] * v0[1]) + (v0[2] * v0[2] + v0[3] * v0[3]) + (v1[0] * v1[0] + v1[1] * v1[1]) + (v1[2] * v1[2] + v1[3] * v1[3]); }
                ss += __shfl_xor(ss, 16); ss += __shfl_xor(ss, 32);
                if (fq == 0) Pt[(ai * 128 + wr * 64 + m * 16 + fr) * 4 + wc] = ss;
            }
        asm volatile("s_waitcnt lgkmcnt(0)" ::: "memory"); __builtin_amdgcn_s_barrier(); asm volatile("" ::: "memory");
        unsigned* pc = cnt + 64 * u.pm;
        if (tid < 256) {
            const f32x4 t = *(const LAS f32x4*)(Pt + tid * 4);
            __hip_atomic_store(X + ((size_t)u.pm * 256 + tid) * 4 + u.pn, (t[0] + t[1]) + (t[2] + t[3]), __ATOMIC_RELAXED, __HIP_MEMORY_SCOPE_AGENT);
            asm volatile("s_waitcnt vmcnt(0)" ::: "memory");
            if ((tid & 63) == 0) __hip_atomic_fetch_add(pc, 1u, __ATOMIC_RELAXED, __HIP_MEMORY_SCOPE_AGENT);
        }
        if (tid < 64) {
            unsigned sp = 0;
            while ((unsigned)__builtin_amdgcn_readfirstlane(__hip_atomic_load(pc, __ATOMIC_RELAXED, __HIP_MEMORY_SCOPE_AGENT)) < 16u && ++sp < (1u << 18)) __builtin_amdgcn_s_sleep(1);
            __builtin_amdgcn_fence(__ATOMIC_ACQUIRE, "agent");
        }
        asm volatile("s_waitcnt vmcnt(0) lgkmcnt(0)" ::: "memory"); __builtin_amdgcn_s_barrier(); asm volatile("" ::: "memory");
        if (tid < 256) {
            float* xs = X + ((size_t)u.pm * 256 + tid) * 4;
            const float t0 = __hip_atomic_load(xs + 0, __ATOMIC_RELAXED, __HIP_MEMORY_SCOPE_AGENT), t1 = __hip_atomic_load(xs + 1, __ATOMIC_RELAXED, __HIP_MEMORY_SCOPE_AGENT),
                        t2 = __hip_atomic_load(xs + 2, __ATOMIC_RELAXED, __HIP_MEMORY_SCOPE_AGENT), t3 = __hip_atomic_load(xs + 3, __ATOMIC_RELAXED, __HIP_MEMORY_SCOPE_AGENT);
            float eps_row = EPS;
            if (psc) {
                const f32x4* pp = (const f32x4*)(psc + ((size_t)u.pm * 256 + tid) * 16);
                const f32x4 a = pp[0], b = pp[1], c = pp[2], d = pp[3];
                const float s = ((a[0] + a[1]) + (a[2] + a[3])) + ((b[0] + b[1]) + (b[2] + b[3])) + ((c[0] + c[1]) + (c[2] + c[3])) + ((d[0] + d[1]) + (d[2] + d[3]));
                const float q = s * (1.f / D) + EPS; eps_row = EPS * q * q;
            }
            St[tid] = rsqrtf(((t0 + t1) + (t2 + t3)) * (1.f / D) + eps_row);
        }
        asm volatile("s_waitcnt vmcnt(0) lgkmcnt(0)" ::: "memory"); __builtin_amdgcn_s_barrier(); asm volatile("" ::: "memory");
        f32x4 gv[2][2];
#pragma unroll
        for (int bj = 0; bj < 2; ++bj) { gv[bj][0] = *(const f32x4*)(g + colw + bj * 128); gv[bj][1] = *(const f32x4*)(g + colw + bj * 128 + 4); }
#pragma unroll
        for (int ai = 0; ai < 2; ++ai) {
            u32x4 hq[4][2];
#pragma unroll
            for (int m = 0; m < 4; ++m)
#pragma unroll
                for (int bj = 0; bj < 2; ++bj) { if (ai == 0) hq[m][bj] = hq0[m][bj]; else hq[m][bj] = *(const u32x4*)(hbase + (size_t)(128 + m * 16) * D + bj * 128); }
#pragma unroll
            for (int m = 0; m < 4; ++m) {
                const int rl = ai * 128 + wr * 64 + m * 16 + fr, row = u.pm * 256 + rl;
                const float rs = St[rl];
                float ss = 0.f;
#pragma unroll
                for (int bj = 0; bj < 2; ++bj) {
                    bf16* hp = HB + (size_t)row * D + colw + bj * 128;
                    const u32x4 hw = hq[m][bj];
                    const f32x4 a0 = acc[ai][bj][m][0] * rs * gv[bj][0], a1 = acc[ai][bj][m][1] * rs * gv[bj][1];
                    const f32x4 o0 = (f32x4){bflo(hw[0]) + a0[0], bfhi(hw[0]) + a0[1], bflo(hw[1]) + a0[2], bfhi(hw[1]) + a0[3]};
                    const f32x4 o1 = (f32x4){bflo(hw[2]) + a1[0], bfhi(hw[2]) + a1[1], bflo(hw[3]) + a1[2], bfhi(hw[3]) + a1[3]};
                    if (FINAL) { float* op = OUT + (size_t)row * D + colw + bj * 128; __builtin_nontemporal_store(o0, (f32x4*)op); __builtin_nontemporal_store(o1, (f32x4*)(op + 4)); }
                    else {
                        ss += (o0[0] * o0[0] + o0[1] * o0[1]) + (o0[2] * o0[2] + o0[3] * o0[3]) + (o1[0] * o1[0] + o1[1] * o1[1]) + (o1[2] * o1[2] + o1[3] * o1[3]);
                        u32x4 w; w.x = pk2(o0[0], o0[1]); w.y = pk2(o0[2], o0[3]); w.z = pk2(o1[0], o1[1]); w.w = pk2(o1[2], o1[3]);
                        *(u32x4*)hp = w;
                    }
                }
                if (!FINAL) { ss += __shfl_xor(ss, 16); ss += __shfl_xor(ss, 32); if (fq == 0) Pt[rl * 4 + wc] = ss; }
            }
        }
        if (!FINAL) {
            asm volatile("s_waitcnt lgkmcnt(0)" ::: "memory"); __builtin_amdgcn_s_barrier(); asm volatile("" ::: "memory");
            const int t2 = fresh_tid(wr * 4 + wc);
            if (t2 < 256) *(f32x4*)(PART + ((size_t)u.pm * 256 + t2) * 16 + u.pn * 4) = *(const LAS f32x4*)(Pt + t2 * 4);
        }
    }
};
struct EpiUp {
    static constexpr bool PERM = true, AFTER_DRAIN = false;
    bf16* U;
    __device__ __forceinline__ void operator()(const pg8::f32x4 (&acc)[2][2][4][2], const pg8::Unit& u, int wr, int wc, int fr, int fq) const {
        const int row0 = u.pm * 256 + wr * 64 + fr, colt = u.pn * 256;
#pragma unroll
        for (int ai = 0; ai < 2; ++ai)
#pragma unroll
            for (int m = 0; m < 4; ++m) {
                const int row = row0 + ai * 128 + m * 16;
                const float sc = 1.f;
                bf16* rowp = U + ((size_t)(u.pm * (FF / 256) + u.pn) * 256 + (row & 255)) * 256 + wc * 32 + 8 * fq;
#pragma unroll
                for (int bj = 0; bj < 2; ++bj) {
                    f32x4 v0 = acc[ai][bj][m][0] * sc, v1 = acc[ai][bj][m][1] * sc;
#pragma unroll
                    for (int e = 0; e < 4; ++e) { const float a = fmaxf(v0[e], 0.f), b = fmaxf(v1[e], 0.f); v0[e] = a * a; v1[e] = b * b; }
                    u32x4 w; w.x = pk2(v0[0], v0[1]); w.y = pk2(v0[2], v0[3]); w.z = pk2(v1[0], v1[1]); w.w = pk2(v1[2], v1[3]);
                    *(u32x4*)(rowp + bj * 128) = w;
                }
            }
    }
};


template <int MODE  >
__device__ __forceinline__ void meta_gemm(LAS unsigned char* lds, const bf16* A, const bf16* Wt, int K, int item, bf16* O, float* PART, const float* rope, const int wave) {
    const int tid = fresh_tid(wave);
    const int lane = tid & 63, fr = lane & 15, fq = lane >> 4;
    const int kw = K >> 3, k0 = wave * kw;
    f32x4 acc[2][2];
#pragma unroll
    for (int g = 0; g < 2; ++g)
#pragma unroll
        for (int n = 0; n < 2; ++n) acc[g][n] = (f32x4){0.f, 0.f, 0.f, 0.f};
    const bf16* ap = A + (size_t)fr * K + k0 + 8 * fq;
    const bf16* bp[2][2];
#pragma unroll
    for (int g = 0; g < 2; ++g)
#pragma unroll
        for (int n = 0; n < 2; ++n) bp[g][n] = Wt + (size_t)(64 * item + 32 * g + pg8::perm32(16 * n + fr)) * K + k0 + 8 * fq;
#pragma unroll 4
    for (int ks = 0; ks < kw; ks += 32) {
        const bf16x8 a = *(const bf16x8*)(ap + ks);
#pragma unroll
        for (int g = 0; g < 2; ++g)
#pragma unroll
            for (int n = 0; n < 2; ++n) { const bf16x8 b = *(const bf16x8*)(bp[g][n] + ks); acc[g][n] = __builtin_amdgcn_mfma_f32_16x16x32_bf16(b, a, acc[g][n], 0, 0, 0); }
    }
    LAS f32x4* red = (LAS f32x4*)lds;
#pragma unroll
    for (int g = 0; g < 2; ++g)
#pragma unroll
        for (int n = 0; n < 2; ++n) red[(wave * 4 + g * 2 + n) * 64 + lane] = acc[g][n];
    __syncthreads();
    if (wave == 0) {
#pragma unroll
        for (int g = 0; g < 2; ++g)
#pragma unroll
            for (int n = 0; n < 2; ++n) { f32x4 t = red[(g * 2 + n) * 64 + lane];
#pragma unroll
                for (int w = 1; w < 8; ++w) t = t + red[(w * 4 + g * 2 + n) * 64 + lane];
                acc[g][n] = t; }
        const int row = META0 + fr;
        if (MODE == 0) {
            const float sc = row_scale(PART, row, fq), sgn = (fq == 0) ? -1.f : 1.f;
            f32x4 cs[4]; { const f32x4* rp = (const f32x4*)(rope + (size_t)fr * 16);
#pragma unroll
                for (int i = 0; i < 4; ++i) cs[i] = rp[i]; }
#pragma unroll
            for (int g = 0; g < 2; ++g) {
                f32x4 v0 = acc[g][0] * sc, v1 = acc[g][1] * sc;
                if (g == 0 && item < 10) {
                    f32x4 p0, p1;
#pragma unroll
                    for (int e = 0; e < 4; ++e) { p0[e] = __shfl_xor(v0[e], 16); p1[e] = __shfl_xor(v1[e], 16); }
                    if (fq < 2) {
#pragma unroll
                        for (int e = 0; e < 4; ++e) {
                            const float c0 = cs[e >> 1][(e & 1) * 2], s0 = cs[e >> 1][(e & 1) * 2 + 1];
                            const float c1 = cs[2 + (e >> 1)][(e & 1) * 2], s1 = cs[2 + (e >> 1)][(e & 1) * 2 + 1];
                            v0[e] = v0[e] * c0 + sgn * p0[e] * s0;
                            v1[e] = v1[e] * c1 + sgn * p1[e] * s1;
                        }
                    }
                }
                if (item < 8) { v0 = v0 * QSCALE; v1 = v1 * QSCALE; }
                if (item >= C_C / 64) {
                    const f32x4 uu = v0 * v1; u32x2 w; w.x = pk2(uu[0], uu[1]); w.y = pk2(uu[2], uu[3]);
                    *(u32x2*)(O + (size_t)row * PW + C_U + ch_ucol(64 * item - C_C + 32 * g + 8 * fq)) = w;
                } else {
                u32x4 w; w.x = pk2(v0[0], v0[1]); w.y = pk2(v0[2], v0[3]); w.z = pk2(v1[0], v1[1]); w.w = pk2(v1[2], v1[3]);
                *(u32x4*)(O + (size_t)row * PW + 64 * item + 32 * g + 8 * fq) = w;
                }
            }
        } else if (MODE == 1) {
            float ss = 0.f;
#pragma unroll
            for (int g = 0; g < 2; ++g) {
                const f32x4 v0 = acc[g][0], v1 = acc[g][1];
                ss += (v0[0] * v0[0] + v0[1] * v0[1]) + (v0[2] * v0[2] + v0[3] * v0[3]) + (v1[0] * v1[0] + v1[1] * v1[1]) + (v1[2] * v1[2] + v1[3] * v1[3]);
                u32x4 w; w.x = pk2(v0[0], v0[1]); w.y = pk2(v0[2], v0[3]); w.z = pk2(v1[0], v1[1]); w.w = pk2(v1[2], v1[3]);
                *(u32x4*)(O + (size_t)row * D + 64 * item + 32 * g + 8 * fq) = w;
            }
            ss += __shfl_xor(ss, 16); ss += __shfl_xor(ss, 32);
            if (fq == 0) PART[(size_t)row * 16 + item] = ss;
        } else {
            const float sc = row_scale(PART, row, fq);
#pragma unroll
            for (int g = 0; g < 2; ++g) {
                f32x4 v0 = acc[g][0] * sc, v1 = acc[g][1] * sc;
#pragma unroll
                for (int e = 0; e < 4; ++e) { const float a = fmaxf(v0[e], 0.f), b = fmaxf(v1[e], 0.f); v0[e] = a * a; v1[e] = b * b; }
                u32x4 w; w.x = pk2(v0[0], v0[1]); w.y = pk2(v0[2], v0[3]); w.z = pk2(v1[0], v1[1]); w.w = pk2(v1[2], v1[3]);
                *(u32x4*)(O + (size_t)row * FF + 64 * item + 32 * g + 8 * fq) = w;
            }
        }
    }
    __syncthreads();
}

template <bool CHPERM>
__device__ __forceinline__ void p0_transpose_item(const float* W, const float* g, int K, int N, bf16* WT, LAS float* scr, int k0, int n0, int lane) {
    const int q4 = lane & 7, kr = lane >> 3;
    int nsrc = n0 + 4 * q4;
    if (CHPERM && nsrc >= C_C) { const int t = nsrc - C_C; nsrc = ((t & 4) ? C_H : C_C) + ch_ucol(t); }
    f32x4 wv[8];
#pragma unroll
    for (int i = 0; i < 8; ++i) wv[i] = __builtin_nontemporal_load((const f32x4*)(W + (size_t)(k0 + 8 * i + kr) * N + nsrc));
    if (g) {
#pragma unroll
        for (int i = 0; i < 8; ++i) wv[i] = wv[i] * g[k0 + 8 * i + kr];
    }
#pragma unroll
    for (int i = 0; i < 8; ++i)
#pragma unroll
        for (int e = 0; e < 4; ++e) scr[(8 * i + kr) * 33 + 4 * q4 + e] = wv[i][e];
    LDS_WAIT(); asm volatile("" ::: "memory");
    const int c = lane & 7;
#pragma unroll
    for (int j = 0; j < 4; ++j) { const int n = (lane >> 3) + 8 * j; const LAS float* s = scr + (8 * c) * 33 + n;
        u32x4 o; o.x = pk2(s[0 * 33], s[1 * 33]); o.y = pk2(s[2 * 33], s[3 * 33]); o.z = pk2(s[4 * 33], s[5 * 33]); o.w = pk2(s[6 * 33], s[7 * 33]);
        *(u32x4*)(WT + (size_t)(n0 + n) * K + k0 + 8 * c) = o; }
    LDS_WAIT(); asm volatile("" ::: "memory");
}
__device__ __forceinline__ void sincos_acc(float x, float& s, float& c) {
    const double xd = (double)x;
    const double kq = __builtin_rint(xd * 0.63661977236758134308);
    double r = __builtin_fma(-kq, 1.57079632679489655800, xd); r = __builtin_fma(-kq, 6.12323399573676603587e-17, r);
    const int q = (int)kq & 3;
    const float rf = (float)r, r2 = rf * rf;
    const float sp = rf + rf * r2 * (-1.6666667163e-01f + r2 * (8.3333337680e-03f + r2 * (-1.9841270114e-04f + r2 * 2.7557314297e-06f)));
    const float cp = 1.0f + r2 * (-0.5f + r2 * (4.1666667908e-02f + r2 * (-1.3888889225e-03f + r2 * (2.4801587642e-05f + r2 * (-2.7557314297e-07f)))));
    s = (q == 0) ? sp : (q == 1) ? cp : (q == 2) ? -sp : -cp;
    c = (q == 0) ? cp : (q == 1) ? -sp : (q == 2) ? -cp : sp;
}
__device__ __forceinline__ void phase0(const Params& P, LAS unsigned char* lds, int G, int wave) {
    const int tid = fresh_tid(wave), lane = tid & 63;
    unsigned char* ws = P.ws;
    LAS float* scr = (LAS float*)(lds + wave * 16384);
    const int gw = blockIdx.x * NWAVES + wave, ngw = G * NWAVES;
    constexpr int I_IN = (D / 64) * (INW / 32), I_OUT = (D / 64) * (D / 32), I_UP = (D / 64) * (FF / 32), I_DN = (FF / 64) * (D / 32), I_L = I_IN + I_OUT + I_UP + I_DN;
    for (int it = gw; it < 2 * I_L; it += ngw) {
        const int l = it / I_L; int r = it - l * I_L;
        unsigned char* wl = ws + WS_W + (size_t)l * W_LAYER;
        if (r < I_IN) { const int nb = INW / 32, kb = r / nb, n = r - kb * nb; p0_transpose_item<true>(P.w_in + (size_t)l * D * INW, P.mix_pre_g + l * D, D, INW, (bf16*)wl, scr, 64 * kb, 32 * n, lane); continue; }
        r -= I_IN;
        if (r < I_OUT) { const int nb = D / 32, kb = r / nb, n = r - kb * nb; const int k0 = 64 * kb;
            const float* g = (k0 < 512) ? (P.attn_out_g + l * 512) : (P.conv_out_g + l * 512 - 512);
            p0_transpose_item<false>(P.w_out + (size_t)l * D * D, g, D, D, (bf16*)(wl + W_IN_B), scr, k0, 32 * n, lane); continue; }
        r -= I_OUT;
        if (r < I_UP) { const int nb = FF / 32, kb = r / nb, n = r - kb * nb; p0_transpose_item<false>(P.w_up + (size_t)l * D * FF, P.mlp_pre_g + l * D, D, FF, (bf16*)(wl + W_IN_B + W_OUT_B), scr, 64 * kb, 32 * n, lane); continue; }
        r -= I_UP;
        { const int nb = D / 32, kb = r / nb, n = r - kb * nb; p0_transpose_item<false>(P.w_down + (size_t)l * FF * D, nullptr, FF, D, (bf16*)(wl + W_IN_B + W_OUT_B + W_UP_B), scr, 64 * kb, 32 * n, lane); }
    }
    bf16* HB = (bf16*)(ws + WS_HB); float* PART = (float*)(ws + WS_PART);
    {
        int m0 = gw;
        for (; m0 + 3 * ngw < M_MAIN; m0 += 4 * ngw) {
            f32x4 v[4][4];
#pragma unroll
            for (int u = 0; u < 4; ++u) { const f32x4* xr = (const f32x4*)(P.x + (size_t)(m0 + u * ngw) * D) + 2 * lane;
#pragma unroll
                for (int j = 0; j < 4; ++j) v[u][j] = __builtin_nontemporal_load(&xr[128 * (j >> 1) + (j & 1)]); }
#pragma unroll
            for (int u = 0; u < 4; ++u) { const int m = m0 + u * ngw; float ss = 0.f;
#pragma unroll
                for (int j = 0; j < 4; ++j) ss += (v[u][j].x * v[u][j].x + v[u][j].y * v[u][j].y) + (v[u][j].z * v[u][j].z + v[u][j].w * v[u][j].w);
                ss = wave_sum(ss);
                u32x4* o16 = (u32x4*)(HB + (size_t)m * D) + lane;
#pragma unroll
                for (int jj = 0; jj < 2; ++jj) { u32x4 o; o.x = pk2(v[u][2 * jj].x, v[u][2 * jj].y); o.y = pk2(v[u][2 * jj].z, v[u][2 * jj].w); o.z = pk2(v[u][2 * jj + 1].x, v[u][2 * jj + 1].y); o.w = pk2(v[u][2 * jj + 1].z, v[u][2 * jj + 1].w); o16[64 * jj] = o; }
                if (lane < 16) PART[(size_t)m * 16 + lane] = (lane == 0) ? ss : 0.f; }
        }
        for (int m = m0; m < M_REAL; m += ngw) {
            const float* src = (m < M_MAIN) ? (P.x + (size_t)m * D) : (P.meta + (size_t)(m - META0) * D);
            const f32x4* xr = (const f32x4*)src + 2 * lane;
            f32x4 v[4]; float ss = 0.f;
#pragma unroll
            for (int j = 0; j < 4; ++j) { v[j] = xr[128 * (j >> 1) + (j & 1)]; ss += (v[j].x * v[j].x + v[j].y * v[j].y) + (v[j].z * v[j].z + v[j].w * v[j].w); }
            ss = wave_sum(ss);
            u32x4* o16 = (u32x4*)(HB + (size_t)m * D) + lane;
#pragma unroll
            for (int jj = 0; jj < 2; ++jj) { u32x4 o; o.x = pk2(v[2 * jj].x, v[2 * jj].y); o.y = pk2(v[2 * jj].z, v[2 * jj].w); o.z = pk2(v[2 * jj + 1].x, v[2 * jj + 1].y); o.w = pk2(v[2 * jj + 1].z, v[2 * jj + 1].w); o16[64 * jj] = o; }
            if (lane < 16) PART[(size_t)m * 16 + lane] = (lane == 0) ? ss : 0.f;
        }
    }
    float* rope = (float*)(ws + WS_ROPE);
    for (int i = blockIdx.x * NTHREADS + tid; i < LPOS * 8; i += G * NTHREADS) {
        const int pos = i >> 3, f = i & 7;
        const float ang = (float)pos * P.inv_freq[f];
        float s, c; sincos_acc(ang, s, c);
        *(f32x2*)(rope + (size_t)i * 2) = (f32x2){c, s};
    }
}

__device__ __forceinline__ void meta_thin(const Params& P, int wave, const float* g) {
    const int lane = fresh_tid(wave) & 63;
    unsigned char* ws = P.ws;
    bf16* HB = (bf16*)(ws + WS_HB); const bf16* Z = (const bf16*)(ws + WS_Z); float* PART = (float*)(ws + WS_PART);
    f32x4 gv[2][2];
#pragma unroll
    for (int jj = 0; jj < 2; ++jj) { gv[jj][0] = *(const f32x4*)(g + 8 * lane + 512 * jj); gv[jj][1] = *(const f32x4*)(g + 8 * lane + 512 * jj + 4); }
#pragma unroll
    for (int i = 0; i < 2; ++i) {
        const int m = META0 + 2 * wave + i;
        const u32x4* hp = (const u32x4*)(HB + (size_t)m * D) + lane; const u32x4* zp = (const u32x4*)(Z + (size_t)m * D) + lane;
        u32x4 hv[2], zv[2];
        hv[0] = hp[0]; hv[1] = hp[64]; zv[0] = zp[0]; zv[1] = zp[64];
        float pp = PART[(size_t)m * 16 + (lane & 15)];
        pp += __shfl_xor(pp, 1); pp += __shfl_xor(pp, 2); pp += __shfl_xor(pp, 4); pp += __shfl_xor(pp, 8);
        const float rs = rsqrtf(pp * (1.f / D) + EPS);
        float o[2][8]; float ss = 0.f;
#pragma unroll
        for (int jj = 0; jj < 2; ++jj)
#pragma unroll
            for (int q = 0; q < 4; ++q) {
                const float h0 = bflo(hv[jj][q]), h1 = bfhi(hv[jj][q]), z0 = bflo(zv[jj][q]), z1 = bfhi(zv[jj][q]);
                const float a = h0 + z0 * rs * gv[jj][q >> 1][(q & 1) * 2], b = h1 + z1 * rs * gv[jj][q >> 1][(q & 1) * 2 + 1];
                o[jj][2 * q] = a; o[jj][2 * q + 1] = b; ss += a * a + b * b;
            }
        ss = wave_sum(ss);
        u32x4* op = (u32x4*)(HB + (size_t)m * D) + lane;
#pragma unroll
        for (int jj = 0; jj < 2; ++jj) { u32x4 w; w.x = pk2(o[jj][0], o[jj][1]); w.y = pk2(o[jj][2], o[jj][3]); w.z = pk2(o[jj][4], o[jj][5]); w.w = pk2(o[jj][6], o[jj][7]); op[64 * jj] = w; }
        if (lane < 16) PART[(size_t)m * 16 + lane] = (lane == 0) ? ss : 0.f;
    }
}
__device__ __forceinline__ void hand_post(unsigned* word, int wave) {
    const int tid = fresh_tid(wave);
    asm volatile("s_waitcnt vmcnt(0)" ::: "memory"); __syncthreads();
    if (tid == 0) { __builtin_amdgcn_fence(__ATOMIC_RELEASE, "agent"); asm volatile("s_waitcnt vmcnt(0)" ::: "memory"); __hip_atomic_fetch_add(word, 1u, __ATOMIC_RELAXED, __HIP_MEMORY_SCOPE_AGENT); }
}
__device__ __forceinline__ void hand_wait(unsigned* word, unsigned need, int wave) {
    const int tid = fresh_tid(wave);
    if (tid == 0) { unsigned sp = 0; while (__hip_atomic_load(word, __ATOMIC_RELAXED, __HIP_MEMORY_SCOPE_AGENT) < need && ++sp < (1u << 22)) __builtin_amdgcn_s_sleep(2);
                    __builtin_amdgcn_fence(__ATOMIC_ACQUIRE, "agent"); asm volatile("s_waitcnt vmcnt(0)" ::: "memory"); }
    __syncthreads();
}

__device__ __forceinline__ int slot_row(bool ismeta, int j, int mq0, int slot) {
    if (ismeta) return (slot >= 128 && slot < 128 + NMETA) ? META0 + slot - 128 : -1;
    if (slot >= 128) return mq0 + slot - 128;
    if (j > 0) return mq0 - 128 + slot;
    return slot >= 128 - NMETA ? META0 + slot - (128 - NMETA) : -1;
}
#define MFMA32(a, b, c) __builtin_amdgcn_mfma_f32_32x32x16_bf16((a), (b), (c), 0, 0, 0)
template <int NROWS>
__device__ __forceinline__ void conv_rows(const bf16* PROJ, bf16* Y, const float* cw, int lane, int mfirst, int p1, int p2) {
    const int c0 = 8 * lane;
    float w0[8], w1[8], w2[8], u1[8], u2[8];
#pragma unroll
    for (int e = 0; e < 8; ++e) { w0[e] = cw[c0 + e]; w1[e] = cw[512 + c0 + e]; w2[e] = cw[1024 + c0 + e]; u1[e] = 0.f; u2[e] = 0.f; }
    if (p1 >= 0) { const u32x4 uv = *(const u32x4*)(PROJ + (size_t)p1 * PW + C_U + c0);
#pragma unroll
        for (int q = 0; q < 4; ++q) { u1[2 * q] = bflo(uv[q]); u1[2 * q + 1] = bfhi(uv[q]); } }
    if (p2 >= 0) { const u32x4 uv = *(const u32x4*)(PROJ + (size_t)p2 * PW + C_U + c0);
#pragma unroll
        for (int q = 0; q < 4; ++q) { u2[2 * q] = bflo(uv[q]); u2[2 * q + 1] = bfhi(uv[q]); } }
#pragma unroll 8
    for (int i = 0; i < NROWS; ++i) {
        const size_t m = (size_t)(mfirst + i);
        const u32x4 bv = *(const u32x4*)(PROJ + m * PW + C_B + c0), uv = *(const u32x4*)(PROJ + m * PW + C_U + c0);
        float y[8], u0[8]; float ss = 0.f;
#pragma unroll
        for (int q = 0; q < 4; ++q) {
            u0[2 * q] = bflo(uv[q]); u0[2 * q + 1] = bfhi(uv[q]);
            y[2 * q] = bflo(bv[q]) * (w0[2 * q] * u2[2 * q] + w1[2 * q] * u1[2 * q] + w2[2 * q] * u0[2 * q]);
            y[2 * q + 1] = bfhi(bv[q]) * (w0[2 * q + 1] * u2[2 * q + 1] + w1[2 * q + 1] * u1[2 * q + 1] + w2[2 * q + 1] * u0[2 * q + 1]);
            ss += y[2 * q] * y[2 * q] + y[2 * q + 1] * y[2 * q + 1];
        }
        ss = wave_sum(ss);
        const float rs = rsqrtf(ss * (1.f / 512.f) + EPS);
        u32x4 w; w.x = pk2(y[0] * rs, y[1] * rs); w.y = pk2(y[2] * rs, y[3] * rs); w.z = pk2(y[4] * rs, y[5] * rs); w.w = pk2(y[6] * rs, y[7] * rs);
        *(u32x4*)(Y + m * D + 512 + c0) = w;
#pragma unroll
        for (int e = 0; e < 8; ++e) { u2[e] = u1[e]; u1[e] = u0[e]; }
    }
}
__device__ __forceinline__ float mask_sel(int m, float v) { return __builtin_bit_cast(float, (__builtin_bit_cast(int, v) & m) | (int)(0xff800000u & ~(unsigned)m)); }
#define MASK_TILE(S, TT) do { \
    if ((TT) == 0) { _Pragma("unroll") for (int e = 0; e < 16; ++e) { const int ce = (e & 3) + 8 * (e >> 2); S[e] = mask_sel((d0 - ce) >> 31, S[e]); } } \
    if ((TT) == 4) { _Pragma("unroll") for (int e = 0; e < 16; ++e) { const int ce = (e & 3) + 8 * (e >> 2); S[e] = mask_sel((ce - d0 - 1) >> 31, S[e]); } } \
    if (lo > 0) { _Pragma("unroll") for (int e = 0; e < 16; ++e) { const int ce = (e & 3) + 8 * (e >> 2); S[e] = mask_sel((lo - 1 - (32 * (sb + (TT)) + 4 * hh + ce)) >> 31, S[e]); } } \
  } while (0)
__device__ __forceinline__ void mixer_unit(const Params& P, LAS unsigned char* lds, int unit, int layer, int wave) {
    const int tid = fresh_tid(wave), lane = tid & 63;
    unsigned char* ws = P.ws;
    const bf16* PROJ = (const bf16*)(ws + WS_PROJ); bf16* Y = (bf16*)(ws + WS_Y);
    const bool ismeta = (unit == 256);
    const int b = unit >> 6, j = unit & 63;
    const int mq0 = ismeta ? META0 : (b * SEQ + 128 * j);
    const int lo = ismeta ? 128 : (j == 0 ? 128 - NMETA : 0);
    const int h = wave, hk = h >> 2, r = lane & 31, hh = lane >> 5;
    bf16x8 qn[4];
    { const bf16* qp = PROJ + (size_t)(mq0 + r) * PW + h * 64 + 8 * hh;
#pragma unroll
      for (int ks = 0; ks < 4; ++ks) qn[ks] = *(const bf16x8*)(qp + 16 * ks); }
    {
    __syncthreads();
#pragma unroll
    for (int it = 0; it < 8; ++it) {
        const int q = tid + NTHREADS * it, slot = q >> 4, c = q & 15; const int row = slot_row(ismeta, j, mq0, slot);
        u32x4 v = (u32x4){0u, 0u, 0u, 0u}; if (row >= 0) v = *(const u32x4*)(PROJ + (size_t)row * PW + C_K + c * 8);
        *(LAS u32x4*)(lds + KL_OFF + (((c >> 3) * 256 + slot) * KL_ROW + (c & 7) * 8) * 2) = v;
    }
#pragma unroll
    for (int it = 0; it < 4; ++it) {
        const int w = tid + NTHREADS * it, sp = w & 127, c = w >> 7; const int r0 = slot_row(ismeta, j, mq0, 2 * sp), r1 = slot_row(ismeta, j, mq0, 2 * sp + 1);
        u32x4 a = (u32x4){0u, 0u, 0u, 0u}, bq = (u32x4){0u, 0u, 0u, 0u};
        if (r0 >= 0) a = *(const u32x4*)(PROJ + (size_t)r0 * PW + C_V + c * 8);
        if (r1 >= 0) bq = *(const u32x4*)(PROJ + (size_t)r1 * PW + C_V + c * 8);
        const int hk = c >> 3, d0 = (c & 7) * 8;
#pragma unroll
        for (int e = 0; e < 8; ++e) {
            const unsigned l16 = (a[e >> 1] >> (16 * (e & 1))) & 0xffffu, h16 = (bq[e >> 1] >> (16 * (e & 1))) & 0xffffu;
            *(LAS unsigned*)(lds + VT_OFF + ((hk * 64 + d0 + e) * VT_ROW + 2 * sp) * 2) = l16 | (h16 << 16);
        }
    }
    __syncthreads();
    }
    const float sink2 = P.sinks[layer * 8 + h] * LOG2E;
    LAS float* SS = (LAS float*)(lds + SS_OFF);
    const int nsb = ismeta ? 1 : 4;
    const float* cw = P.conv_w + (size_t)layer * 3 * 512;
    const int c0 = 8 * lane, cfirst = mq0 + 16 * wave;
    float cu1[8], cu2[8];
#pragma unroll
    for (int e = 0; e < 8; ++e) { cu1[e] = 0.f; cu2[e] = 0.f; }
    if (!ismeta) {
        const int s0 = cfirst & (SEQ - 1);
        const int p1 = (s0 == 0) ? META0 + 15 : cfirst - 1, p2 = (s0 == 0) ? META0 + 14 : cfirst - 2;
        const u32x4 a1 = *(const u32x4*)(PROJ + (size_t)p1 * PW + C_U + c0), a2 = *(const u32x4*)(PROJ + (size_t)p2 * PW + C_U + c0);
#pragma unroll
        for (int q = 0; q < 4; ++q) { cu1[2 * q] = bflo(a1[q]); cu1[2 * q + 1] = bfhi(a1[q]); cu2[2 * q] = bflo(a2[q]); cu2[2 * q + 1] = bfhi(a2[q]); }
    }
#pragma nounroll
    for (int sb = 0; sb < nsb; ++sb) {
        u32x4 cbv[4], cuv[4];
        if (!ismeta) {
#pragma unroll
            for (int i = 0; i < 4; ++i) { const size_t m = (size_t)(cfirst + 4 * sb + i); cbv[i] = *(const u32x4*)(PROJ + m * PW + C_B + c0); cuv[i] = *(const u32x4*)(PROJ + m * PW + C_U + c0); }
        }
        int rr = r; asm volatile("" : "+v"(rr));
        const int d0 = rr - 4 * hh;
        bf16x8 qf[4];
#pragma unroll
        for (int ks = 0; ks < 4; ++ks) qf[ks] = qn[ks];
        if (sb + 1 < nsb) { const bf16* qp = PROJ + (size_t)(mq0 + 32 * (sb + 1) + r) * PW + h * 64 + 8 * hh;
#pragma unroll
            for (int ks = 0; ks < 4; ++ks) qn[ks] = *(const bf16x8*)(qp + 16 * ks); }
        const LAS unsigned char* kbase = lds + KL_OFF + ((hk * 256 + 32 * sb + r) * KL_ROW + 8 * hh) * 2;
        const LAS unsigned char* vbase = lds + VT_OFF + ((hk * 64 + r) * VT_ROW + 32 * sb + 4 * hh) * 2;
        f32x16 s[5];
#pragma unroll
        for (int tt = 0; tt < 5; ++tt) {
#pragma unroll
            for (int e = 0; e < 16; ++e) s[tt][e] = 0.f;
#pragma unroll
            for (int ks = 0; ks < 4; ++ks) { const bf16x8 kf = *(const LAS bf16x8*)(kbase + tt * (32 * KL_ROW * 2) + 32 * ks); s[tt] = MFMA32(kf, qf[ks], s[tt]); }
        }
#pragma unroll
        for (int tt = 0; tt < 5; ++tt) MASK_TILE(s[tt], tt);
        float mx = sink2;
#pragma unroll
        for (int tt = 0; tt < 5; ++tt)
#pragma unroll
            for (int e = 0; e < 16; ++e) mx = fmaxf(mx, s[tt][e]);
        mx = fmaxf(mx, __shfl_xor(mx, 32));
        float sum = 0.f;
        f32x16 o[2];
#pragma unroll
        for (int e = 0; e < 16; ++e) { o[0][e] = 0.f; o[1][e] = 0.f; }
#pragma unroll
        for (int tt = 0; tt < 5; ++tt) {
#pragma unroll
            for (int e = 0; e < 16; ++e) { const float ev = __builtin_amdgcn_exp2f(s[tt][e] - mx); s[tt][e] = ev; sum += ev; }
#pragma unroll
            for (int st = 0; st < 2; ++st) {
                u32x4 pw; pw.x = pk2(s[tt][8 * st + 0], s[tt][8 * st + 1]); pw.y = pk2(s[tt][8 * st + 2], s[tt][8 * st + 3]); pw.z = pk2(s[tt][8 * st + 4], s[tt][8 * st + 5]); pw.w = pk2(s[tt][8 * st + 6], s[tt][8 * st + 7]);
                const bf16x8 pf = __builtin_bit_cast(bf16x8, pw);
#pragma unroll
                for (int dh = 0; dh < 2; ++dh) {
                    const LAS unsigned char* vb = vbase + dh * (32 * VT_ROW * 2) + (32 * tt + 16 * st) * 2;
                    const u32x2 v0 = *(const LAS u32x2*)vb, v1 = *(const LAS u32x2*)(vb + 16);
                    const bf16x8 vf = __builtin_bit_cast(bf16x8, (u32x4){v0.x, v0.y, v1.x, v1.y});
                    o[dh] = MFMA32(vf, pf, o[dh]);
                }
            }
        }
        sum += __shfl_xor(sum, 32);
        const float inv = 1.0f / (sum + __builtin_amdgcn_exp2f(sink2 - mx));
        float ssq = 0.f;
#pragma unroll
        for (int dh = 0; dh < 2; ++dh)
#pragma unroll
            for (int e = 0; e < 16; ++e) { const float a = o[dh][e] * inv; o[dh][e] = a; ssq += a * a; }
        ssq += __shfl_xor(ssq, 32);
        LAS float* ssp = SS + (sb & 1) * 256;
        if (hh == 0) ssp[h * 32 + r] = ssq;
        asm volatile("s_waitcnt lgkmcnt(0)" ::: "memory"); __builtin_amdgcn_s_barrier(); asm volatile("" ::: "memory");
        float tot = 0.f;
#pragma unroll
        for (int h2 = 0; h2 < 8; ++h2) tot += ssp[h2 * 32 + r];
        const float rsn = rsqrtf(tot * (1.f / 512.f) + EPS);
        bf16* yp = Y + (size_t)(mq0 + 32 * sb + r) * D + h * 64 + 8 * hh;
        const bool st_ok = !ismeta || r < NMETA;
#pragma unroll
        for (int kp = 0; kp < 4; ++kp) {
            const int dh = kp >> 1, g4 = 2 * (kp & 1);
            unsigned ax = pk2(o[dh][4 * g4] * rsn, o[dh][4 * g4 + 1] * rsn), ay = pk2(o[dh][4 * g4 + 2] * rsn, o[dh][4 * g4 + 3] * rsn);
            unsigned bx = pk2(o[dh][4 * g4 + 4] * rsn, o[dh][4 * g4 + 5] * rsn), by = pk2(o[dh][4 * g4 + 6] * rsn, o[dh][4 * g4 + 7] * rsn);
            { const auto rx = __builtin_amdgcn_permlane32_swap(ax, bx, false, false); ax = rx[0]; bx = rx[1]; }
            { const auto ry = __builtin_amdgcn_permlane32_swap(ay, by, false, false); ay = ry[0]; by = ry[1]; }
            if (st_ok) *(u32x4*)(yp + 16 * kp) = (u32x4){ax, ay, bx, by};
        }
        if (!ismeta) {
            float w0[8], w1[8], w2[8];
#pragma unroll
            for (int e = 0; e < 8; ++e) { w0[e] = cw[c0 + e]; w1[e] = cw[512 + c0 + e]; w2[e] = cw[1024 + c0 + e]; }
#pragma unroll
            for (int i = 0; i < 4; ++i) {
                float y[8], u0[8]; float ss = 0.f;
#pragma unroll
                for (int q = 0; q < 4; ++q) {
                    u0[2 * q] = bflo(cuv[i][q]); u0[2 * q + 1] = bfhi(cuv[i][q]);
                    y[2 * q] = bflo(cbv[i][q]) * (w0[2 * q] * cu2[2 * q] + w1[2 * q] * cu1[2 * q] + w2[2 * q] * u0[2 * q]);
                    y[2 * q + 1] = bfhi(cbv[i][q]) * (w0[2 * q + 1] * cu2[2 * q + 1] + w1[2 * q + 1] * cu1[2 * q + 1] + w2[2 * q + 1] * u0[2 * q + 1]);
                    ss += y[2 * q] * y[2 * q] + y[2 * q + 1] * y[2 * q + 1];
                }
                ss = wave_sum(ss);
                const float rsc = rsqrtf(ss * (1.f / 512.f) + EPS);
                u32x4 w; w.x = pk2(y[0] * rsc, y[1] * rsc); w.y = pk2(y[2] * rsc, y[3] * rsc); w.z = pk2(y[4] * rsc, y[5] * rsc); w.w = pk2(y[6] * rsc, y[7] * rsc);
                *(u32x4*)(Y + (size_t)(cfirst + 4 * sb + i) * D + 512 + c0) = w;
#pragma unroll
                for (int e = 0; e < 8; ++e) { cu2[e] = cu1[e]; cu1[e] = u0[e]; }
            }
        }
    }
    if (ismeta) {
        const int i0 = 2 * wave;
        conv_rows<2>(PROJ, Y, cw, lane, META0 + i0, i0 >= 1 ? META0 + i0 - 1 : -1, i0 >= 2 ? META0 + i0 - 2 : -1);
    }
}

#ifndef WGM_IN
#define WGM_IN 4
#endif
#ifndef WGM_UP
#define WGM_UP 4
#endif
#ifndef WGM_RES
#define WGM_RES 4
#endif
__global__ void __launch_bounds__(NTHREADS, 2) hymba_fwd(Params P) {
    extern __shared__ __attribute__((aligned(16))) unsigned char lds_raw[];
    LAS unsigned char* lds = (LAS unsigned char*)lds_raw;
    volatile LAS unsigned* MISC = (volatile LAS unsigned*)(lds + MISC_OFF);
    const int wave = __builtin_amdgcn_readfirstlane((int)threadIdx.x >> 6);
    const int G = gridDim.x;
    unsigned char* ws = P.ws;
    { const int t0 = fresh_tid(wave); if (t0 < 32) MISC[t0] = 0u; }
    __syncthreads();
    XcdBarrier bar = xcd_barrier_post((unsigned*)(ws + WS_CTL) + CW_BAR, MISC + 8, wave);

    {
    phase0(P, lds, G, wave);
    cg::this_grid().sync();
    }

    bf16* HB = (bf16*)(ws + WS_HB); bf16* Z = (bf16*)(ws + WS_Z); bf16* U = (bf16*)(ws + WS_U); bf16* PROJ = (bf16*)(ws + WS_PROJ); bf16* Y = (bf16*)(ws + WS_Y);
    float* PART = (float*)(ws + WS_PART); const float* rope = (const float*)(ws + WS_ROPE);
    unsigned* ctl = (unsigned*)(ws + WS_CTL);
#pragma unroll
    for (int l = 0; l < 2; ++l) {
        const unsigned char* wl = ws + WS_W + (size_t)l * W_LAYER;
        const bf16* W_IN = (const bf16*)wl; const bf16* W_OUT = (const bf16*)(wl + W_IN_B); const bf16* W_UP = (const bf16*)(wl + W_IN_B + W_OUT_B); const bf16* W_DN = (const bf16*)(wl + W_IN_B + W_OUT_B + W_UP_B);
        {
        if (l == 1 && blockIdx.x == 0) { meta_thin(P, wave, P.mlp_post_g); hand_post(ctl + CW_T + 64, wave); }
        { pg8::Gemm g{HB, W_IN, M_MAIN, INW, D}; pg8::StaticOrder S; S.init(M_MAIN, INW, G, (int)blockIdx.x, WGM_IN); EpiIn E{PROJ, PART, rope};
          pg8::gemm_phase<EpiIn, pg8::StaticOrder, true, true>(lds, g, S, E, wave); }
        { const int mb = (int)blockIdx.x - (G - 1 - INW / 64);
          unsigned* mcnt = ctl + CW_META + 64 * l;
          if (mb >= 0 && mb < INW / 64) {
              if (l == 1) hand_wait(ctl + CW_T + 64, 1u, wave);
              meta_gemm<0>(lds, HB + (size_t)META0 * D, W_IN, D, mb, PROJ, PART, rope, wave);
              if (l == 0) hand_post(mcnt, wave);
          }
          if (l == 0 && (int)blockIdx.x == G - 1) { hand_wait(mcnt, (unsigned)(INW / 64), wave); mixer_unit(P, lds, 256, l, wave); }
        }
        xcd_barrier(bar);
        }
        {
        for (int unit = blockIdx.x; unit < 256; unit += G) mixer_unit(P, lds, unit, l, wave);
        xcd_barrier(bar);
        }
        { pg8::Gemm g{Y, W_OUT, M_MAIN, D, D}; pg8::StaticOrder S; S.init(M_MAIN, D, G, (int)blockIdx.x, WGM_RES);
          EpiRes<false> E{HB, nullptr, P.mix_post_g + l * D, (float*)(ws + WS_PARTB), (float*)(ws + WS_X) + (size_t)(2 * l) * 131072, ctl + CW_X + (2 * l) * 8192, lds, nullptr};
          pg8::gemm_phase<EpiRes<false>, pg8::StaticOrder, true, true>(lds, g, S, E, wave); }
        if (l == 0 && (int)blockIdx.x < D / 64) meta_gemm<1>(lds, Y + (size_t)META0 * D, W_OUT, D, (int)blockIdx.x, Z, PART, rope, wave);
        xcd_barrier(bar);
        {
        if (l == 0 && blockIdx.x == 0) { meta_thin(P, wave, P.mix_post_g); hand_post(ctl + CW_T, wave); }
        { pg8::Gemm g{HB, W_UP, M_MAIN, FF, D}; pg8::StaticOrder S; S.init(M_MAIN, FF, G, (int)blockIdx.x, WGM_UP); EpiUp E{U};
          pg8::gemm_phase<EpiUp, pg8::StaticOrder, true, true>(lds, g, S, E, wave); }
        if (l == 0 && (int)blockIdx.x < FF / 64) { hand_wait(ctl + CW_T, 1u, wave); meta_gemm<2>(lds, HB + (size_t)META0 * D, W_UP, D, (int)blockIdx.x, U, PART, rope, wave); }
        xcd_barrier(bar);
        }
        if (l == 0) {
            { pg8::Gemm g{U, W_DN, M_MAIN, D, FF}; pg8::StaticOrder S; S.init(M_MAIN, D, G, (int)blockIdx.x, WGM_RES);
              EpiRes<false> E{HB, nullptr, P.mlp_post_g, PART, (float*)(ws + WS_X) + (size_t)1 * 131072, ctl + CW_X + 1 * 8192, lds, (const float*)(ws + WS_PARTB)};
              pg8::gemm_phase<EpiRes<false>, pg8::StaticOrder, true, true, true>(lds, g, S, E, wave); }
            if ((int)blockIdx.x < D / 64) meta_gemm<1>(lds, U + (size_t)META0 * FF, W_DN, FF, (int)blockIdx.x, Z, PART, rope, wave);
            xcd_barrier(bar);
        } else {
            pg8::Gemm g{U, W_DN, M_MAIN, D, FF}; pg8::StaticOrder S; S.init(M_MAIN, D, G, (int)blockIdx.x, WGM_RES);
            EpiRes<true> E{HB, P.out, P.mlp_post_g + D, PART, (float*)(ws + WS_X) + (size_t)3 * 131072, ctl + CW_X + 3 * 8192, lds, (const float*)(ws + WS_PARTB)};
            pg8::gemm_phase<EpiRes<true>, pg8::StaticOrder, true, true, true>(lds, g, S, E, wave);
        }
    }
}

extern "C" void kernel_launch(void* const* d_in, const int* in_sizes, int n_in, void* d_out, int out_size, void* d_ws, size_t ws_size, hipStream_t stream) {
    static int grid = 0;
    if (grid == 0) {
        if (n_in != 14 || in_sizes[0] != M_MAIN * D || out_size != M_MAIN * D || ws_size < WS_END) {
            fprintf(stderr, "kernel_launch: unexpected shapes (n_in %d, in0 %d, out %d, ws %zu < %zu); nothing launched\n", n_in, n_in > 0 ? in_sizes[0] : -1, out_size, ws_size, (size_t)WS_END); grid = -1; return; }
        int dev = 0, cus = 0, per_cu = 0;
        if (hipGetDevice(&dev) != hipSuccess || hipDeviceGetAttribute(&cus, hipDeviceAttributeMultiprocessorCount, dev) != hipSuccess) { fprintf(stderr, "kernel_launch: device query failed\n"); grid = -1; return; }
        if (hipFuncSetAttribute((const void*)hymba_fwd, hipFuncAttributeMaxDynamicSharedMemorySize, LDS_BYTES) != hipSuccess) { fprintf(stderr, "kernel_launch: hipFuncSetAttribute failed\n"); grid = -1; return; }
        if (hipOccupancyMaxActiveBlocksPerMultiprocessor(&per_cu, (const void*)hymba_fwd, NTHREADS, LDS_BYTES) != hipSuccess || per_cu < 1) { fprintf(stderr, "kernel_launch: occupancy query says %d\n", per_cu); per_cu = 1; }
        (void)hipGetLastError();
        if (cus != 256) { fprintf(stderr, "kernel_launch: built for a 256-CU device (fused epilogues pair four workgroups per round); found %d CUs; nothing launched\n", cus); grid = -1; return; }
        grid = cus * 1;
    }
    if (grid < 0) return;
    if (hipMemsetAsync((char*)d_ws + WS_CTL, 0, CTL_BYTES, stream) != hipSuccess) { fprintf(stderr, "kernel_launch: memset failed\n"); return; }
    Params p{};
    p.x = (const float*)d_in[0]; p.meta = (const float*)d_in[1]; p.mix_pre_g = (const float*)d_in[2]; p.w_in = (const float*)d_in[3]; p.conv_w = (const float*)d_in[4];
    p.sinks = (const float*)d_in[5]; p.attn_out_g = (const float*)d_in[6]; p.conv_out_g = (const float*)d_in[7]; p.w_out = (const float*)d_in[8]; p.mix_post_g = (const float*)d_in[9];
    p.mlp_pre_g = (const float*)d_in[10]; p.w_up = (const float*)d_in[11]; p.w_down = (const float*)d_in[12]; p.mlp_post_g = (const float*)d_in[13];
    p.out = (float*)d_out; p.ws = (unsigned char*)d_ws;
    for (int i = 0; i < 8; ++i) p.inv_freq[i] = (float)pow(500000.0, -(double)i / 8.0);
    void* args[] = {&p};
    const hipError_t e = hipLaunchCooperativeKernel((const void*)hymba_fwd, dim3(grid), dim3(NTHREADS), args, LDS_BYTES, stream);
    if (e != hipSuccess) fprintf(stderr, "kernel_launch: cooperative launch failed: %s (grid %d)\n", hipGetErrorString(e), grid);
}
```

```cpp
#include <hip/hip_runtime.h>
#include <hip/hip_cooperative_groups.h>
#include <cstdio>
#include <cstdint>
#include <cmath>
namespace cg = cooperative_groups;
__device__ __forceinline__ int fresh_tid(int wave) { int l; asm volatile("v_mbcnt_lo_u32_b32 %0, -1, 0\n\tv_mbcnt_hi_u32_b32 %0, -1, %0" : "=v"(l)); return wave * 64 + l; }
namespace pg8 {
#define PG8_LAS __attribute__((address_space(3)))
typedef unsigned short bf16_t;
typedef short bf16x8 __attribute__((ext_vector_type(8)));
typedef float f32x4 __attribute__((ext_vector_type(4)));
typedef unsigned u32x4 __attribute__((ext_vector_type(4)));
constexpr int BM = 256, BK = 64, HALF = 128, HTB = HALF * BK * 2  , STAGE_BYTES = 8 * HTB, NXCD = 8, WGM = 8;

__host__ __device__ __forceinline__ int lds_byte(int r, int c) { const int st = (r >> 4) * 2 + (c >> 5), rr = r & 15, cc = c & 31, ob = rr * 64 + cc * 2; return st * 1024 + (ob ^ (((ob >> 9) & 1) << 5)); }
__host__ __device__ __forceinline__ void stage_rc(int b, int& R, int& C) { const int st = b / 1024, sb = b % 1024, swz = sb ^ (((sb >> 9) & 1) << 5); R = (st >> 1) * 16 + swz / 64; C = (st & 1) * 32 + (swz % 64) / 2; }
__host__ __device__ __forceinline__ int perm32(int rho) { const int n = rho >> 4, i = rho & 15; return 8 * (i >> 2) + 4 * n + (i & 3); }

struct Unit { int pm, pn; };
struct Gemm { const bf16_t* A; const bf16_t* Bt; int M, N, K; };

struct StaticOrder {
    int nM, nN, nwg, G, c, wgm;
    __host__ __device__ void init(int M, int N, int G_, int c_, int wgm_ = WGM) { nM = M / BM; nN = N / BM; nwg = nM * nN; G = G_; c = c_; wgm = wgm_; }
    __host__ __device__ bool next(int i, Unit& u) const {
        const long L = (long)i * G + c; if (L >= nwg) return false;
        int wgid = (int)L; { const int q = nwg / NXCD, r = nwg % NXCD, xcd = wgid % NXCD, off = wgid / NXCD; wgid = (xcd < r ? xcd * (q + 1) : r * (q + 1) + (xcd - r) * q) + off; }
        const int nig = wgm * nN, gid = wgid / nig, fm = gid * wgm, gsz = (nM - fm) < wgm ? (nM - fm) : wgm;
        u.pm = fm + ((wgid % nig) % gsz); u.pn = (wgid % nig) / gsz; return true;
    }
    __device__ __forceinline__ void a_ready(const Unit&) const {}
    __device__ __forceinline__ void done(const Unit&) const {}
};
__device__ __forceinline__ unsigned cvt_pk_bf16(float lo, float hi) { unsigned r; asm volatile("v_cvt_pk_bf16_f32 %0, %1, %2" : "=v"(r) : "v"(lo), "v"(hi)); return r; }
template <class Epi, class Sched, bool ALIGN_EPI = false, bool SP2 = false, bool ATILED = false>
__device__ __forceinline__ void gemm_phase(PG8_LAS unsigned char* lds, const Gemm g, const Sched& S, const Epi& E, const int wave_id) {
    const int tid = fresh_tid(wave_id);
    const int wid = wave_id, lane = tid & 63, wr = wid >> 2, wc = wid & 3, fr = lane & 15, fq = lane >> 4;
    const int K = g.K, nt = K / BK;
    unsigned voffA[2], voffB[2];
#pragma unroll
    for (int i = 0; i < 2; ++i) { int R, C; stage_rc(tid * 16 + i * 8192, R, C); const int Rb = Epi::PERM ? ((R & ~31) + perm32(R & 31)) : R;
        voffA[i] = (unsigned)(R * (ATILED ? 256 : K) + C) * 2u; voffB[i] = (unsigned)(Rb * K + C) * 2u; }
    const size_t kstep = (size_t)(BK * 2);
    const size_t hstep = (size_t)HALF * K * 2, hstepA = ATILED ? (size_t)HALF * 256 * 2 : hstep;
    const size_t tstep = 2 * hstep;
    const unsigned ldsw = (unsigned)wid * 1024u;
    const int aoff = lds_byte(wr * 64 + fr, fq * 8), boff = lds_byte(wc * 32 + fr, fq * 8);
#define PG8_SA(b, h) (((b) * 2 + (h)) * HTB)
#define PG8_SB(b, h) ((4 + (b) * 2 + (h)) * HTB)
#define PG8_STAGE(bufoff, gbase, voff) do { _Pragma("unroll") for (int _i = 0; _i < 2; ++_i) \
        __builtin_amdgcn_global_load_lds((const unsigned*)((const char*)(gbase) + (voff)[_i]), (PG8_LAS unsigned*)(lds + (bufoff) + ldsw + _i * 8192), 16, 0, 0); } while (0)
#define PG8_LDA(dst, b, h) do { _Pragma("unroll") for (int m = 0; m < 4; ++m) _Pragma("unroll") for (int k = 0; k < 2; ++k) dst[m][k] = *(const PG8_LAS bf16x8*)(lds + PG8_SA(b, h) + aoff + m * 2048 + k * 1024); } while (0)
#define PG8_LDB(dst, b, h) do { _Pragma("unroll") for (int n = 0; n < 2; ++n) _Pragma("unroll") for (int k = 0; k < 2; ++k) dst[n][k] = *(const PG8_LAS bf16x8*)(lds + PG8_SB(b, h) + boff + n * 2048 + k * 1024); } while (0)
#define PG8_MMA(ai, bj, At, Bt) do { __builtin_amdgcn_s_setprio(1); _Pragma("unroll") for (int m = 0; m < 4; ++m) _Pragma("unroll") for (int n = 0; n < 2; ++n) _Pragma("unroll") for (int k = 0; k < 2; ++k) \
        acc[ai][bj][m][n] = __builtin_amdgcn_mfma_f32_16x16x32_bf16(Bt[n][k], At[m][k], acc[ai][bj][m][n], 0, 0, 0); __builtin_amdgcn_s_setprio(0); } while (0)
#define PG8_WAIT_V(n) asm volatile("s_waitcnt vmcnt(" #n ")" ::: "memory")
#define PG8_WAIT_L(n) asm volatile("s_waitcnt lgkmcnt(" #n ")" ::: "memory")
#define PG8_BAR __builtin_amdgcn_s_barrier()
#define PG8_SCHED __builtin_amdgcn_sched_barrier(0)
    Unit cur, nxt; int ui = 0;
    if (!S.next(0, cur)) return;
    f32x4 acc[2][2][4][2];
#pragma unroll
    for (int a = 0; a < 2; ++a)
#pragma unroll
        for (int b = 0; b < 2; ++b)
#pragma unroll
            for (int m = 0; m < 4; ++m)
#pragma unroll
                for (int n = 0; n < 2; ++n) acc[a][b][m][n] = (f32x4){0.f, 0.f, 0.f, 0.f};
    bf16x8 At[4][2], B0[2][2], B1[2][2];
    const char* cA = (const char*)g.A + (size_t)cur.pm * tstep; const char* cB = (const char*)g.Bt + (size_t)cur.pn * tstep;
    S.a_ready(cur);
    if constexpr (SP2) {
        PG8_STAGE(PG8_SB(0, 0), cB, voffB); PG8_STAGE(PG8_SB(0, 1), cB + hstep, voffB); PG8_STAGE(PG8_SA(0, 0), cA, voffA); PG8_STAGE(PG8_SA(0, 1), cA + hstepA, voffA);
        if (wr == 1) PG8_BAR;
        PG8_WAIT_V(2); PG8_BAR;
        PG8_STAGE(PG8_SB(1, 0), cB + kstep, voffB); PG8_STAGE(PG8_SA(1, 0), cA + kstep, voffA); PG8_STAGE(PG8_SB(1, 1), cB + hstep + kstep, voffB);
        PG8_WAIT_V(6); PG8_BAR;
    } else {
        PG8_STAGE(PG8_SB(0, 0), cB, voffB); PG8_STAGE(PG8_SA(0, 0), cA, voffA); PG8_STAGE(PG8_SB(0, 1), cB + hstep, voffB); PG8_STAGE(PG8_SA(0, 1), cA + hstepA, voffA);
        if (wr == 1) PG8_BAR;
        PG8_WAIT_V(4); PG8_BAR;
        PG8_STAGE(PG8_SB(1, 0), cB + kstep, voffB); PG8_STAGE(PG8_SA(1, 0), cA + kstep, voffA); PG8_STAGE(PG8_SB(1, 1), cB + hstep + kstep, voffB);
        PG8_WAIT_V(6); PG8_BAR;
    }
    for (;;) {
        const bool has_next = S.next(ui + 1, nxt);
        const char* nA = has_next ? (const char*)g.A + (size_t)nxt.pm * tstep : cA; const char* nB = has_next ? (const char*)g.Bt + (size_t)nxt.pn * tstep : cB;
        for (int t = 0; t < nt; t += 2) {
            const bool last = (t == nt - 2);
            const char* a1 = cA + (ATILED ? (size_t)((t + 1) >> 2) * 131072 + (size_t)((t + 1) & 3) * kstep : (size_t)(t + 1) * kstep);
            const char* a2 = last ? nA : cA + (ATILED ? (size_t)((t + 2) >> 2) * 131072 + (size_t)((t + 2) & 3) * kstep : (size_t)(t + 2) * kstep); const char* b2 = last ? nB : cB + (size_t)(t + 2) * kstep;
            const char* a3 = a2 + kstep; const char* b3 = b2 + kstep;
            if (last && has_next) S.a_ready(nxt);
            if constexpr (SP2) {
            PG8_LDB(B0, 0, 0); PG8_LDB(B1, 0, 1); PG8_SCHED; PG8_LDA(At, 0, 0); PG8_STAGE(PG8_SA(1, 1), a1 + hstepA, voffA);
            PG8_WAIT_V(8); PG8_WAIT_L(0); PG8_BAR; PG8_MMA(0, 0, At, B0); PG8_MMA(0, 1, At, B1); PG8_BAR; PG8_SCHED;
            PG8_LDA(At, 0, 1); PG8_STAGE(PG8_SB(0, 0), b2, voffB); PG8_STAGE(PG8_SB(0, 1), b2 + hstep, voffB); PG8_STAGE(PG8_SA(0, 0), a2, voffA);
            PG8_WAIT_V(8); PG8_WAIT_L(0); PG8_BAR; PG8_MMA(1, 0, At, B0); PG8_MMA(1, 1, At, B1); PG8_BAR; PG8_SCHED;
            PG8_LDB(B0, 1, 0); PG8_LDB(B1, 1, 1); PG8_SCHED; PG8_LDA(At, 1, 0); PG8_STAGE(PG8_SA(0, 1), a2 + hstepA, voffA);
            PG8_WAIT_V(8); PG8_WAIT_L(0); PG8_BAR; PG8_MMA(0, 0, At, B0); PG8_MMA(0, 1, At, B1); PG8_BAR; PG8_SCHED;
            PG8_LDA(At, 1, 1); PG8_STAGE(PG8_SB(1, 0), b3, voffB); PG8_STAGE(PG8_SB(1, 1), b3 + hstep, voffB); PG8_STAGE(PG8_SA(1, 0), a3, voffA);
            PG8_WAIT_V(8); PG8_WAIT_L(0); PG8_BAR; PG8_MMA(1, 0, At, B0); PG8_MMA(1, 1, At, B1); PG8_BAR; PG8_SCHED;
            } else {
            PG8_LDB(B0, 0, 0); PG8_SCHED; PG8_LDA(At, 0, 0); PG8_STAGE(PG8_SA(1, 1), a1 + hstepA, voffA);
            PG8_WAIT_L(8); PG8_BAR; PG8_WAIT_L(0); PG8_MMA(0, 0, At, B0); PG8_BAR; PG8_SCHED;
            PG8_LDB(B1, 0, 1); PG8_STAGE(PG8_SB(0, 0), b2, voffB);
            PG8_BAR; PG8_WAIT_L(0); PG8_MMA(0, 1, At, B1); PG8_BAR;
            PG8_LDA(At, 0, 1); PG8_STAGE(PG8_SA(0, 0), a2, voffA);
            PG8_BAR; PG8_WAIT_L(0); PG8_MMA(1, 0, At, B0); PG8_BAR; PG8_SCHED;
            PG8_STAGE(PG8_SB(0, 1), b2 + hstep, voffB);
            PG8_WAIT_V(6); PG8_BAR; PG8_MMA(1, 1, At, B1); PG8_BAR;
            PG8_LDB(B0, 1, 0); PG8_SCHED; PG8_LDA(At, 1, 0); PG8_STAGE(PG8_SA(0, 1), a2 + hstepA, voffA);
            PG8_WAIT_L(8); PG8_BAR; PG8_WAIT_L(0); PG8_MMA(0, 0, At, B0); PG8_BAR; PG8_SCHED;
            PG8_LDB(B1, 1, 1); PG8_STAGE(PG8_SB(1, 0), b3, voffB);
            PG8_BAR; PG8_WAIT_L(0); PG8_MMA(0, 1, At, B1); PG8_BAR;
            PG8_LDA(At, 1, 1); PG8_STAGE(PG8_SA(1, 0), a3, voffA);
            PG8_BAR; PG8_WAIT_L(0); PG8_MMA(1, 0, At, B0); PG8_BAR; PG8_SCHED;
            PG8_STAGE(PG8_SB(1, 1), b3 + hstep, voffB);
            PG8_WAIT_V(6); PG8_BAR; PG8_MMA(1, 1, At, B1); PG8_BAR;
            }
        }
        if constexpr (ALIGN_EPI) { if (wr == 0) PG8_BAR; }
        if constexpr (!Epi::AFTER_DRAIN) { E(acc, cur, wr, wc, fr, fq); S.done(cur); }
        if (!has_next) break;
#pragma unroll
        for (int a = 0; a < 2; ++a)
#pragma unroll
            for (int b = 0; b < 2; ++b)
#pragma unroll
                for (int m = 0; m < 4; ++m)
#pragma unroll
                    for (int n = 0; n < 2; ++n) acc[a][b][m][n] = (f32x4){0.f, 0.f, 0.f, 0.f};
        cur = nxt; cA = nA; cB = nB; ++ui;
        if constexpr (ALIGN_EPI) { if (wr == 1) PG8_BAR; }
    }
    PG8_WAIT_V(0);
    if constexpr (!ALIGN_EPI) { if (wr == 0) PG8_BAR; }
    PG8_BAR;
    if constexpr (Epi::AFTER_DRAIN) { E.fused(acc, cur, wr, wc, fr, fq, lds, wid, lane); S.done(cur); }
#undef PG8_SA
#undef PG8_SB
#undef PG8_STAGE
#undef PG8_LDA
#undef PG8_LDB
#undef PG8_MMA
#undef PG8_WAIT_V
#undef PG8_WAIT_L
#undef PG8_BAR
#undef PG8_SCHED
}
}
#define GAS __attribute__((address_space(1)))
#define LAS __attribute__((address_space(3)))
typedef unsigned short bf16;
typedef unsigned u32x4 __attribute__((ext_vector_type(4)));
typedef unsigned u32x2 __attribute__((ext_vector_type(2)));
typedef float f32x4 __attribute__((ext_vector_type(4)));
typedef float f32x2 __attribute__((ext_vector_type(2)));
typedef float f32x16 __attribute__((ext_vector_type(16)));
typedef short bf16x8 __attribute__((ext_vector_type(8)));
typedef __bf16 bf16v2 __attribute__((ext_vector_type(2)));
#define LDS_WAIT() asm volatile("s_waitcnt lgkmcnt(0)" ::: "memory")
__device__ __forceinline__ unsigned pk2(float lo, float hi) { return __builtin_bit_cast(unsigned, __builtin_convertvector((f32x2){lo, hi}, bf16v2)); }
__device__ __forceinline__ float bflo(unsigned w) { return __builtin_bit_cast(float, w << 16); }
__device__ __forceinline__ float bfhi(unsigned w) { return __builtin_bit_cast(float, w & 0xffff0000u); }
__device__ __forceinline__ float wave_sum(float v) {
#pragma unroll
    for (int o = 1; o < 64; o <<= 1) v += __shfl_xor(v, o);
    return v;
}
#define XB_TMO      128
#define XB_XCNT(j)  (256  + 64 * (j))
#define XB_XSUB(j)  (1280 + 64 * (j))
#define XB_XGEN(j)  (2304 + 64 * (j))
#define XB_TOP      3328
#define XB_TOPGEN   3392
#define XCD_BAR_WORDS 3456
#define XB_SPIN_CAP (1u << 18)

__device__ __forceinline__ unsigned xb_ld(unsigned* p)              { return __hip_atomic_load(p, __ATOMIC_RELAXED, __HIP_MEMORY_SCOPE_AGENT); }
__device__ __forceinline__ unsigned xb_add(unsigned* p, unsigned v) { return __hip_atomic_fetch_add(p, v, __ATOMIC_RELAXED, __HIP_MEMORY_SCOPE_AGENT); }
__device__ __forceinline__ unsigned xb_xcc_id() { return (unsigned)__builtin_amdgcn_s_getreg((3 << 11) | 20) & 0xFu; }
#define XB_SPIN(cond, bar) do { unsigned _sp = 0; while (cond) { __builtin_amdgcn_s_sleep(1); \
    if ((++_sp & 255u) == 0u) { if (xb_ld(&(bar)[XB_TMO])) break; if (_sp > XB_SPIN_CAP) { atomicAdd(&(bar)[XB_TMO], 1u); break; } } } } while (0)

struct XcdBarrier {
    unsigned* bar; unsigned x; int w;
    volatile LAS unsigned* st;
};

__device__ __forceinline__ XcdBarrier xcd_barrier_post(unsigned* bar, volatile LAS unsigned* st, int wave) {
    XcdBarrier b; b.bar = bar; b.x = xb_xcc_id(); b.st = st; b.w = wave;
    if (fresh_tid(wave) == 0) (void)xb_add(&bar[XB_XCNT(b.x)], 1u);
    return b;
}
__device__ __forceinline__ void xcd_barrier_complete(unsigned* bar, unsigned x, unsigned& nloc, unsigned& nx) {
    const unsigned G = gridDim.x * gridDim.y * gridDim.z;
    unsigned sum, cnt, mine, sp = 0u;
    for (;;) {
        sum = 0u; cnt = 0u; mine = 0u;
#pragma unroll
        for (unsigned j = 0; j < 16; ++j) { const unsigned c = xb_ld(&bar[XB_XCNT(j)]); sum += c; cnt += (c > 0u) ? 1u : 0u; mine = (j == x) ? c : mine; }
        if (sum == G) break;
        __builtin_amdgcn_s_sleep(1);
        if ((++sp & 255u) == 0u) { if (xb_ld(&bar[XB_TMO])) break; if (sp > XB_SPIN_CAP) { atomicAdd(&bar[XB_TMO], 1u); break; } }
    }
    nloc = mine > 0u ? mine : 1u; nx = cnt > 0u ? cnt : 1u;
}

__device__ __forceinline__ void xcd_barrier(const XcdBarrier& b) {
    asm volatile("s_waitcnt vmcnt(0)" ::: "memory");
    __syncthreads();
    if (fresh_tid(b.w) == 0) {
        unsigned* bar = b.bar;
        __builtin_amdgcn_s_waitcnt(0);
        unsigned nloc = b.st[0], nx = b.st[1];
        if (nloc == 0u) { xcd_barrier_complete(bar, b.x, nloc, nx); b.st[0] = nloc; b.st[1] = nx; }
        const unsigned old = xb_add(&bar[XB_XSUB(b.x)], 1u);
        const unsigned gen = old / nloc;
        if (old + 1u == (gen + 1u) * nloc) {
            __builtin_amdgcn_fence(__ATOMIC_RELEASE, "agent");
            asm volatile("s_waitcnt vmcnt(0)" ::: "memory");
            (void)xb_add(&bar[XB_TOP], 1u);
        }
        XB_SPIN(xb_ld(&bar[XB_TOP]) < (gen + 1u) * nx, bar);
        __builtin_amdgcn_fence(__ATOMIC_ACQUIRE, "agent");
        asm volatile("s_waitcnt vmcnt(0)" ::: "memory");
    }
    __syncthreads();
}

constexpr int D = 1024, SEQ = 8192, NBATCH = 4, NMETA = 16;
constexpr int M_MAIN = NBATCH * SEQ;
constexpr int META0 = M_MAIN;
constexpr int M_REAL = M_MAIN + NMETA;
constexpr int M_PAD = M_MAIN + 256;
constexpr int INW = 2304, FF = 4096;
constexpr int C_K = 512, C_V = 640, C_B = 768, C_C = 1280, C_H = 1792;
constexpr int PW = 1792, C_U = 1280;
constexpr int LPOS = SEQ + NMETA;
constexpr float EPS = 1e-6f;
constexpr float LOG2E = 1.4426950408889634f;
constexpr float QSCALE = 0.125f * LOG2E;
constexpr int NWAVES = 8, NTHREADS = 512;

constexpr size_t MiB = 1u << 20;
constexpr size_t WS_CTL = 0, CTL_BYTES = 256 * 1024;
constexpr size_t WS_ROPE = 1 * MiB;
constexpr size_t WS_PART = 3 * MiB;
constexpr size_t WS_W = 6 * MiB;
constexpr size_t W_IN_B = (size_t)INW * D * 2, W_OUT_B = (size_t)D * D * 2, W_UP_B = (size_t)FF * D * 2, W_DN_B = (size_t)D * FF * 2;
constexpr size_t W_LAYER = W_IN_B + W_OUT_B + W_UP_B + W_DN_B;
constexpr size_t ROWB = (size_t)M_PAD * 2;
constexpr size_t WS_HB = WS_W + 2 * W_LAYER;
constexpr size_t WS_Z = WS_HB + ROWB * D;
constexpr size_t WS_U = WS_Z + ROWB * D;
constexpr size_t WS_PROJ = WS_U;
constexpr size_t WS_Y = WS_PROJ + ROWB * PW;
constexpr size_t WS_END = WS_U + ROWB * FF;
static_assert(WS_Y + ROWB * D <= WS_END, "Y inside U's overlay");
constexpr int CW_BAR = 1024;
constexpr int CW_T = 12288;
constexpr int CW_X = 16384;
constexpr size_t WS_X = WS_Z;
constexpr size_t WS_PARTB = WS_Z + 4 * MiB;
constexpr int XL_OFF = 131072;
constexpr int CW_META = 8192;

constexpr int KL_OFF = 0, KL_ROW = 72;
constexpr int VT_OFF = 2 * 256 * KL_ROW * 2, VT_ROW = 260;
constexpr int SS_OFF = VT_OFF + 2 * 64 * VT_ROW * 2;
constexpr int MISC_OFF = SS_OFF + 8 * 128 * 4;
constexpr int LDS_BYTES = 147456;
static_assert(MISC_OFF + 128 <= LDS_BYTES && MISC_OFF >= 131072, "LDS map");

struct Params {
    const float *x, *meta, *mix_pre_g, *w_in, *conv_w, *sinks, *attn_out_g, *conv_out_g, *w_out, *mix_post_g, *mlp_pre_g, *w_up, *w_down, *mlp_post_g;
    float* out; unsigned char* ws;
    float inv_freq[8];
};

__host__ __device__ __forceinline__ int ch_ucol(int t  ) { const int w = t & 255; return 128 * (t >> 8) + 8 * (4 * ((w >> 5) & 3) + ((w >> 3) & 3)) + 4 * (w >> 7) + (w & 3); }
__device__ __forceinline__ float row_scale_of(const f32x4 t) {
    float s = (t[0] + t[1]) + (t[2] + t[3]);
    s += __shfl_xor(s, 16); s += __shfl_xor(s, 32);
    return rsqrtf(s * (1.f / D) + EPS);
}
__device__ __forceinline__ float row_scale(const float* part, int row, int fq) {
    const f32x4 t = *(const f32x4*)(part + (size_t)row * 16 + 4 * fq);
    float s = (t[0] + t[1]) + (t[2] + t[3]);
    s += __shfl_xor(s, 16); s += __shfl_xor(s, 32);
    return rsqrtf(s * (1.f / D) + EPS);
}
__device__ __forceinline__ void rope_step16(f32x4 (&cs)[4]) {
    { const float c = cs[0][0], s = cs[0][1]; cs[0][0] = c * -9.576594830e-01f - s * -2.879033089e-01f; cs[0][1] = s * -9.576594830e-01f + c * -2.879033089e-01f; }
    { const float c = cs[0][2], s = cs[0][3]; cs[0][2] = c * -9.992462397e-01f - s * 3.881900758e-02f; cs[0][3] = s * -9.992462397e-01f + c * 3.881900758e-02f; }
    { const float c = cs[1][0], s = cs[1][1]; cs[1][0] = c * 8.243765235e-01f - s * 5.660418272e-01f; cs[1][1] = s * 8.243765235e-01f + c * 5.660418272e-01f; }
    { const float c = cs[1][2], s = cs[1][3]; cs[1][2] = c * 9.932003021e-01f - s * 1.164180413e-01f; cs[1][3] = s * 9.932003021e-01f + c * 1.164180413e-01f; }
    { const float c = cs[2][0], s = cs[2][1]; cs[2][0] = c * 9.997439981e-01f - s * 2.262548544e-02f; cs[2][1] = s * 9.997439981e-01f + c * 2.262548544e-02f; }
    { const float c = cs[2][2], s = cs[2][3]; cs[2][2] = c * 9.999903440e-01f - s * 4.387957044e-03f; cs[2][3] = s * 9.999903440e-01f + c * 4.387957044e-03f; }
    { const float c = cs[3][0], s = cs[3][1]; cs[3][0] = c * 9.999996424e-01f - s * 8.509272011e-04f; cs[3][1] = s * 9.999996424e-01f + c * 8.509272011e-04f; }
    { const float c = cs[3][2], s = cs[3][3]; cs[3][2] = c * 1.000000000e+00f - s * 1.650141639e-04f; cs[3][3] = s * 1.000000000e+00f + c * 1.650141639e-04f; }
}
__device__ __forceinline__ void rope_step80(f32x4 (&cs)[4]) {
    { const float c = cs[0][0], s = cs[0][1]; cs[0][0] = c * -1.103872433e-01f - s * -9.938886762e-01f; cs[0][1] = s * -1.103872433e-01f + c * -9.938886762e-01f; }
    { const float c = cs[0][2], s = cs[0][3]; cs[0][2] = c * -9.812132120e-01f - s * 1.929264963e-01f; cs[0][3] = s * -9.812132120e-01f + c * 1.929264963e-01f; }
    { const float c = cs[1][0], s = cs[1][1]; cs[1][0] = c * -9.911538959e-01f - s * 1.327174604e-01f; cs[1][1] = s * -9.911538959e-01f + c * 1.327174604e-01f; }
    { const float c = cs[1][2], s = cs[1][3]; cs[1][2] = c * 8.345872760e-01f - s * 5.508757234e-01f; cs[1][3] = s * 8.345872760e-01f + c * 5.508757234e-01f; }
    { const float c = cs[2][0], s = cs[2][1]; cs[2][0] = c * 9.936068058e-01f - s * 1.128958836e-01f; cs[2][1] = s * 9.936068058e-01f + c * 1.128958836e-01f; }
    { const float c = cs[2][2], s = cs[2][3]; cs[2][2] = c * 9.997593164e-01f - s * 2.193809487e-02f; cs[2][3] = s * 9.997593164e-01f + c * 2.193809487e-02f; }
    { const float c = cs[3][0], s = cs[3][1]; cs[3][0] = c * 9.999909401e-01f - s * 4.254623782e-03f; cs[3][1] = s * 9.999909401e-01f + c * 4.254623782e-03f; }
    { const float c = cs[3][2], s = cs[3][3]; cs[3][2] = c * 9.999996424e-01f - s * 8.250707178e-04f; cs[3][3] = s * 9.999996424e-01f + c * 8.250707178e-04f; }
}
struct EpiIn {
    static constexpr bool PERM = true, AFTER_DRAIN = false;
    bf16* O; const float* part; const float* rope;
    __device__ __forceinline__ void operator()(const pg8::f32x4 (&acc)[2][2][4][2], const pg8::Unit& u, int wr, int wc, int fr, int fq) const {
        const int row0 = u.pm * 256 + wr * 64 + fr, colt = u.pn * 256;
        const bool ropewave = (u.pn <= 2) && ((wc & 1) == 0);
        const float sgn = (fq == 0) ? -1.f : 1.f;
        float scv[2][4]; f32x4 ptv[2][4];
        f32x4 cs[4];
        if (ropewave) { const f32x4* rp = (const f32x4*)(rope + (size_t)((row0 & (SEQ - 1)) + NMETA) * 16);
#pragma unroll
            for (int i = 0; i < 4; ++i) cs[i] = rp[i]; }
#pragma unroll
        for (int ai = 0; ai < 2; ++ai)
#pragma unroll
            for (int m = 0; m < 4; ++m) ptv[ai][m] = *(const f32x4*)(part + (size_t)(row0 + ai * 128 + m * 16) * 16 + 4 * fq);
#pragma unroll
        for (int ai = 0; ai < 2; ++ai)
#pragma unroll
            for (int m = 0; m < 4; ++m) scv[ai][m] = row_scale_of(ptv[ai][m]);
#pragma unroll
        for (int gp = 0; gp < 4; ++gp) {
            const int ai = gp >> 1;
#pragma unroll
            for (int mm = 0; mm < 2; ++mm) {
                const int m = 2 * (gp & 1) + mm;
                const int row = row0 + ai * 128 + m * 16;
                const float sc = scv[ai][m];
                if (ropewave && (gp | mm) != 0) { if (m == 0) rope_step80(cs); else rope_step16(cs); }
                bf16* rowp = O + (size_t)row * PW + colt + wc * 32 + 8 * fq;
                if (u.pn >= 5) {
                    const f32x4 u0 = (acc[ai][0][m][0] * sc) * (acc[ai][0][m][1] * sc), u1 = (acc[ai][1][m][0] * sc) * (acc[ai][1][m][1] * sc);
                    u32x4 w; w.x = pk2(u0[0], u0[1]); w.y = pk2(u0[2], u0[3]); w.z = pk2(u1[0], u1[1]); w.w = pk2(u1[2], u1[3]);
                    *(u32x4*)(O + (size_t)row * PW + C_U + 128 * (u.pn - 5) + 8 * (4 * wc + fq)) = w;
                    continue;
                }
#pragma unroll
                for (int bj = 0; bj < 2; ++bj) {
                    f32x4 v0 = acc[ai][bj][m][0] * sc, v1 = acc[ai][bj][m][1] * sc;
                    if (ropewave && (u.pn < 2 || bj == 0)) {
                        f32x4 p0, p1;
#pragma unroll
                        for (int e = 0; e < 4; ++e) { p0[e] = __shfl_xor(v0[e], 16); p1[e] = __shfl_xor(v1[e], 16); }
                        if (fq < 2) {
#pragma unroll
                            for (int e = 0; e < 4; ++e) {
                                const float c0 = cs[e >> 1][(e & 1) * 2], s0 = cs[e >> 1][(e & 1) * 2 + 1];
                                const float c1 = cs[2 + (e >> 1)][(e & 1) * 2], s1 = cs[2 + (e >> 1)][(e & 1) * 2 + 1];
                                v0[e] = v0[e] * c0 + sgn * p0[e] * s0;
                                v1[e] = v1[e] * c1 + sgn * p1[e] * s1;
                            }
                        }
                    }
                    if (u.pn < 2) { v0 = v0 * QSCALE; v1 = v1 * QSCALE; }
                    u32x4 w; w.x = pk2(v0[0], v0[1]); w.y = pk2(v0[2], v0[3]); w.z = pk2(v1[0], v1[1]); w.w = pk2(v1[2], v1[3]);
                    *(u32x4*)(rowp + bj * 128) = w;
                }
            }
        }
    }
};
template <bool FINAL> struct EpiRes {
    static constexpr bool PERM = true, AFTER_DRAIN = false;
    bf16* HB; float* OUT; const float* g; float* PART; float* X; unsigned* cnt; LAS unsigned char* lds;
    const float* psc;
    __device__ __forceinline__ void operator()(const pg8::f32x4 (&acc)[2][2][4][2], const pg8::Unit& u, int wr, int wc, int fr, int fq) const {
        LAS float* Pt = (LAS float*)(lds + XL_OFF); LAS float* St = Pt + 1024;
        const int tid = (wr * 4 + wc) * 64 + fq * 16 + fr;
        const int colw = u.pn * 256 + wc * 32 + 8 * fq;
        bf16* hbase = HB + (size_t)(u.pm * 256 + wr * 64 + fr) * D + colw;
        u32x4 hq0[4][2];
#pragma unroll
        for (int m = 0; m < 4; ++m)
#pragma unroll
            for (int bj = 0; bj < 2; ++bj) hq0[m][bj] = *(const u32x4*)(hbase + (size_t)(m * 16) * D + bj * 128);
#pragma unroll
        for (int ai = 0; ai < 2; ++ai)
#pragma unroll
            for (int m = 0; m < 4; ++m) {
                float ss = 0.f;
#pragma unroll
                for (int bj = 0; bj < 2; ++bj) { const f32x4 v0 = acc[ai][bj][m][0], v1 = acc[ai][bj][m][1];
                    ss += (v0[0] * v0[0] + v0[1] * v0[1]) + (v0[2] * v0[2] + v0[3] * v0[3]) + (v1[0] * v1[0] + v1[1] * v1[1]) + (v1[2] * v1[2] + v1[3] * v1[3]); }
                ss += __shfl_xor(ss, 16); ss += __shfl_xor(ss, 32);
                if (fq == 0) Pt[(ai * 128 + wr * 64 + m * 16 + fr) * 4 + wc] = ss;
            }
        asm volatile("s_waitcnt lgkmcnt(0)" ::: "memory"); __builtin_amdgcn_s_barrier(); asm volatile("" ::: "memory");
        unsigned* pc = cnt + 64 * u.pm;
        if (tid < 256) {
            const f32x4 t = *(const LAS f32x4*)(Pt + tid * 4);
            __hip_atomic_store(X + ((size_t)u.pm * 256 + tid) * 4 + u.pn, (t[0] + t[1]) + (t[2] + t[3]), __ATOMIC_RELAXED, __HIP_MEMORY_SCOPE_AGENT);
            asm volatile("s_waitcnt vmcnt(0)" ::: "memory");
            if ((tid & 63) == 0) __hip_atomic_fetch_add(pc, 1u, __ATOMIC_RELAXED, __HIP_MEMORY_SCOPE_AGENT);
        }
        if (tid < 64) {
            unsigned sp = 0;
            while ((unsigned)__builtin_amdgcn_readfirstlane(__hip_atomic_load(pc, __ATOMIC_RELAXED, __HIP_MEMORY_SCOPE_AGENT)) < 16u && ++sp < (1u << 18)) __builtin_amdgcn_s_sleep(1);
            __builtin_amdgcn_fence(__ATOMIC_ACQUIRE, "agent");
        }
        asm volatile("s_waitcnt vmcnt(0) lgkmcnt(0)" ::: "memory"); __builtin_amdgcn_s_barrier(); asm volatile("" ::: "memory");
        if (tid < 256) {
            float* xs = X + ((size_t)u.pm * 256 + tid) * 4;
            const float t0 = __hip_atomic_load(xs + 0, __ATOMIC_RELAXED, __HIP_MEMORY_SCOPE_AGENT), t1 = __hip_atomic_load(xs + 1, __ATOMIC_RELAXED, __HIP_MEMORY_SCOPE_AGENT),
                        t2 = __hip_atomic_load(xs + 2, __ATOMIC_RELAXED, __HIP_MEMORY_SCOPE_AGENT), t3 = __hip_atomic_load(xs + 3, __ATOMIC_RELAXED, __HIP_MEMORY_SCOPE_AGENT);
            float eps_row = EPS;
            if (psc) {
                const f32x4* pp = (const f32x4*)(psc + ((size_t)u.pm * 256 + tid) * 16);
                const f32x4 a = pp[0], b = pp[1], c = pp[2], d = pp[3];
                const float s = ((a[0] + a[1]) + (a[2] + a[3])) + ((b[0] + b[1]) + (b[2] + b[3])) + ((c[0] + c[1]) + (c[2] + c[3])) + ((d[0] + d[1]) + (d[2] + d[3]));
                const float q = s * (1.f / D) + EPS; eps_row = EPS * q * q;
            }
            St[tid] = rsqrtf(((t0 + t1) + (t2 + t3)) * (1.f / D) + eps_row);
        }
        asm volatile("s_waitcnt vmcnt(0) lgkmcnt(0)" ::: "memory"); __builtin_amdgcn_s_barrier(); asm volatile("" ::: "memory");
        f32x4 gv[2][2];
#pragma unroll
        for (int bj = 0; bj < 2; ++bj) { gv[bj][0] = *(const f32x4*)(g + colw + bj * 128); gv[bj][1] = *(const f32x4*)(g + colw + bj * 128 + 4); }
#pragma unroll
        for (int ai = 0; ai < 2; ++ai) {
            u32x4 hq[4][2];
#pragma unroll
            for (int m = 0; m < 4; ++m)
#pragma unroll
                for (int bj = 0; bj < 2; ++bj) { if (ai == 0) hq[m][bj] = hq0[m][bj]; else hq[m][bj] = *(const u32x4*)(hbase + (size_t)(128 + m * 16) * D + bj * 128); }
#pragma unroll
            for (int m = 0; m < 4; ++m) {
                const int rl = ai * 128 + wr * 64 + m * 16 + fr, row = u.pm * 256 + rl;
                const float rs = St[rl];
                float ss = 0.f;
#pragma unroll
                for (int bj = 0; bj < 2; ++bj) {
                    bf16* hp = HB + (size_t)row * D + colw + bj * 128;
                    const u32x4 hw = hq[m][bj];
                    const f32x4 a0 = acc[ai][bj][m][0] * rs * gv[bj][0], a1 = acc[ai][bj][m][1] * rs * gv[bj][1];
                    const f32x4 o0 = (f32x4){bflo(hw[0]) + a0[0], bfhi(hw[0]) + a0[1], bflo(hw[1]) + a0[2], bfhi(hw[1]) + a0[3]};
                    const f32x4 o1 = (f32x4){bflo(hw[2]) + a1[0], bfhi(hw[2]) + a1[1], bflo(hw[3]) + a1[2], bfhi(hw[3]) + a1[3]};
                    if (FINAL) { float* op = OUT + (size_t)row * D + colw + bj * 128; *(f32x4*)op = o0; *(f32x4*)(op + 4) = o1; }
                    else {
                        ss += (o0[0] * o0[0] + o0[1] * o0[1]) + (o0[2] * o0[2] + o0[3] * o0[3]) + (o1[0] * o1[0] + o1[1] * o1[1]) + (o1[2] * o1[2] + o1[3] * o1[3]);
                        u32x4 w; w.x = pk2(o0[0], o0[1]); w.y = pk2(o0[2], o0[3]); w.z = pk2(o1[0], o1[1]); w.w = pk2(o1[2], o1[3]);
                        *(u32x4*)hp = w;
                    }
                }
                if (!FINAL) { ss += __shfl_xor(ss, 16); ss += __shfl_xor(ss, 32); if (fq == 0) Pt[rl * 4 + wc] = ss; }
            }
        }
        if (!FINAL) {
            asm volatile("s_waitcnt lgkmcnt(0)" ::: "memory"); __builtin_amdgcn_s_barrier(); asm volatile("" ::: "memory");
            const int t2 = fresh_tid(wr * 4 + wc);
            if (t2 < 256) *(f32x4*)(PART + ((size_t)u.pm * 256 + t2) * 16 + u.pn * 4) = *(const LAS f32x4*)(Pt + t2 * 4);
        }
    }
};
struct EpiUp {
    static constexpr bool PERM = true, AFTER_DRAIN = false;
    bf16* U;
    __device__ __forceinline__ void operator()(const pg8::f32x4 (&acc)[2][2][4][2], const pg8::Unit& u, int wr, int wc, int fr, int fq) const {
        const int row0 = u.pm * 256 + wr * 64 + fr, colt = u.pn * 256;
#pragma unroll
        for (int ai = 0; ai < 2; ++ai)
#pragma unroll
            for (int m = 0; m < 4; ++m) {
                const int row = row0 + ai * 128 + m * 16;
                const float sc = 1.f;
                bf16* rowp = U + ((size_t)(u.pm * (FF / 256) + u.pn) * 256 + (row & 255)) * 256 + wc * 32 + 8 * fq;
#pragma unroll
                for (int bj = 0; bj < 2; ++bj) {
                    f32x4 v0 = acc[ai][bj][m][0] * sc, v1 = acc[ai][bj][m][1] * sc;
#pragma unroll
                    for (int e = 0; e < 4; ++e) { const float a = fmaxf(v0[e], 0.f), b = fmaxf(v1[e], 0.f); v0[e] = a * a; v1[e] = b * b; }
                    u32x4 w; w.x = pk2(v0[0], v0[1]); w.y = pk2(v0[2], v0[3]); w.z = pk2(v1[0], v1[1]); w.w = pk2(v1[2], v1[3]);
                    *(u32x4*)(rowp + bj * 128) = w;
                }
            }
    }
};


template <int MODE  >
__device__ __forceinline__ void meta_gemm(LAS unsigned char* lds, const bf16* A, const bf16* Wt, int K, int item, bf16* O, float* PART, const float* rope, const int wave) {
    const int tid = fresh_tid(wave);
    const int lane = tid & 63, fr = lane & 15, fq = lane >> 4;
    const int kw = K >> 3, k0 = wave * kw;
    f32x4 acc[2][2];
#pragma unroll
    for (int g = 0; g < 2; ++g)
#pragma unroll
        for (int n = 0; n < 2; ++n) acc[g][n] = (f32x4){0.f, 0.f, 0.f, 0.f};
    const bf16* ap = A + (size_t)fr * K + k0 + 8 * fq;
    const bf16* bp[2][2];
#pragma unroll
    for (int g = 0; g < 2; ++g)
#pragma unroll
        for (int n = 0; n < 2; ++n) bp[g][n] = Wt + (size_t)(64 * item + 32 * g + pg8::perm32(16 * n + fr)) * K + k0 + 8 * fq;
#pragma unroll 4
    for (int ks = 0; ks < kw; ks += 32) {
        const bf16x8 a = *(const bf16x8*)(ap + ks);
#pragma unroll
        for (int g = 0; g < 2; ++g)
#pragma unroll
            for (int n = 0; n < 2; ++n) { const bf16x8 b = *(const bf16x8*)(bp[g][n] + ks); acc[g][n] = __builtin_amdgcn_mfma_f32_16x16x32_bf16(b, a, acc[g][n], 0, 0, 0); }
    }
    LAS f32x4* red = (LAS f32x4*)lds;
#pragma unroll
    for (int g = 0; g < 2; ++g)
#pragma unroll
        for (int n = 0; n < 2; ++n) red[(wave * 4 + g * 2 + n) * 64 + lane] = acc[g][n];
    __syncthreads();
    if (wave == 0) {
#pragma unroll
        for (int g = 0; g < 2; ++g)
#pragma unroll
            for (int n = 0; n < 2; ++n) { f32x4 t = red[(g * 2 + n) * 64 + lane];
#pragma unroll
                for (int w = 1; w < 8; ++w) t = t + red[(w * 4 + g * 2 + n) * 64 + lane];
                acc[g][n] = t; }
        const int row = META0 + fr;
        if (MODE == 0) {
            const float sc = row_scale(PART, row, fq), sgn = (fq == 0) ? -1.f : 1.f;
            f32x4 cs[4]; { const f32x4* rp = (const f32x4*)(rope + (size_t)fr * 16);
#pragma unroll
                for (int i = 0; i < 4; ++i) cs[i] = rp[i]; }
#pragma unroll
            for (int g = 0; g < 2; ++g) {
                f32x4 v0 = acc[g][0] * sc, v1 = acc[g][1] * sc;
                if (g == 0 && item < 10) {
                    f32x4 p0, p1;
#pragma unroll
                    for (int e = 0; e < 4; ++e) { p0[e] = __shfl_xor(v0[e], 16); p1[e] = __shfl_xor(v1[e], 16); }
                    if (fq < 2) {
#pragma unroll
                        for (int e = 0; e < 4; ++e) {
                            const float c0 = cs[e >> 1][(e & 1) * 2], s0 = cs[e >> 1][(e & 1) * 2 + 1];
                            const float c1 = cs[2 + (e >> 1)][(e & 1) * 2], s1 = cs[2 + (e >> 1)][(e & 1) * 2 + 1];
                            v0[e] = v0[e] * c0 + sgn * p0[e] * s0;
                            v1[e] = v1[e] * c1 + sgn * p1[e] * s1;
                        }
                    }
                }
                if (item < 8) { v0 = v0 * QSCALE; v1 = v1 * QSCALE; }
                if (item >= C_C / 64) {
                    const f32x4 uu = v0 * v1; u32x2 w; w.x = pk2(uu[0], uu[1]); w.y = pk2(uu[2], uu[3]);
                    *(u32x2*)(O + (size_t)row * PW + C_U + ch_ucol(64 * item - C_C + 32 * g + 8 * fq)) = w;
                } else {
                u32x4 w; w.x = pk2(v0[0], v0[1]); w.y = pk2(v0[2], v0[3]); w.z = pk2(v1[0], v1[1]); w.w = pk2(v1[2], v1[3]);
                *(u32x4*)(O + (size_t)row * PW + 64 * item + 32 * g + 8 * fq) = w;
                }
            }
        } else if (MODE == 1) {
            float ss = 0.f;
#pragma unroll
            for (int g = 0; g < 2; ++g) {
                const f32x4 v0 = acc[g][0], v1 = acc[g][1];
                ss += (v0[0] * v0[0] + v0[1] * v0[1]) + (v0[2] * v0[2] + v0[3] * v0[3]) + (v1[0] * v1[0] + v1[1] * v1[1]) + (v1[2] * v1[2] + v1[3] * v1[3]);
                u32x4 w; w.x = pk2(v0[0], v0[1]); w.y = pk2(v0[2], v0[3]); w.z = pk2(v1[0], v1[1]); w.w = pk2(v1[2], v1[3]);
                *(u32x4*)(O + (size_t)row * D + 64 * item + 32 * g + 8 * fq) = w;
            }
            ss += __shfl_xor(ss, 16); ss += __shfl_xor(ss, 32);
            if (fq == 0) PART[(size_t)row * 16 + item] = ss;
        } else {
            const float sc = row_scale(PART, row, fq);
#pragma unroll
            for (int g = 0; g < 2; ++g) {
                f32x4 v0 = acc[g][0] * sc, v1 = acc[g][1] * sc;
#pragma unroll
                for (int e = 0; e < 4; ++e) { const float a = fmaxf(v0[e], 0.f), b = fmaxf(v1[e], 0.f); v0[e] = a * a; v1[e] = b * b; }
                u32x4 w; w.x = pk2(v0[0], v0[1]); w.y = pk2(v0[2], v0[3]); w.z = pk2(v1[0], v1[1]); w.w = pk2(v1[2], v1[3]);
                *(u32x4*)(O + (size_t)row * FF + 64 * item + 32 * g + 8 * fq) = w;
            }
        }
    }
    __syncthreads();
}

template <bool CHPERM>
__device__ __forceinline__ void p0_transpose_item(const float* W, const float* g, int K, int N, bf16* WT, LAS float* scr, int k0, int n0, int lane) {
    const int q4 = lane & 7, kr = lane >> 3;
    int nsrc = n0 + 4 * q4;
    if (CHPERM && nsrc >= C_C) { const int t = nsrc - C_C; nsrc = ((t & 4) ? C_H : C_C) + ch_ucol(t); }
    f32x4 wv[8];
#pragma unroll
    for (int i = 0; i < 8; ++i) wv[i] = __builtin_nontemporal_load((const f32x4*)(W + (size_t)(k0 + 8 * i + kr) * N + nsrc));
    if (g) {
#pragma unroll
        for (int i = 0; i < 8; ++i) wv[i] = wv[i] * g[k0 + 8 * i + kr];
    }
#pragma unroll
    for (int i = 0; i < 8; ++i)
#pragma unroll
        for (int e = 0; e < 4; ++e) scr[(8 * i + kr) * 33 + 4 * q4 + e] = wv[i][e];
    LDS_WAIT(); asm volatile("" ::: "memory");
    const int c = lane & 7;
#pragma unroll
    for (int j = 0; j < 4; ++j) { const int n = (lane >> 3) + 8 * j; const LAS float* s = scr + (8 * c) * 33 + n;
        u32x4 o; o.x = pk2(s[0 * 33], s[1 * 33]); o.y = pk2(s[2 * 33], s[3 * 33]); o.z = pk2(s[4 * 33], s[5 * 33]); o.w = pk2(s[6 * 33], s[7 * 33]);
        *(u32x4*)(WT + (size_t)(n0 + n) * K + k0 + 8 * c) = o; }
    LDS_WAIT(); asm volatile("" ::: "memory");
}
__device__ __forceinline__ void sincos_acc(float x, float& s, float& c) {
    const double xd = (double)x;
    const double kq = __builtin_rint(xd * 0.63661977236758134308);
    double r = __builtin_fma(-kq, 1.57079632679489655800, xd); r = __builtin_fma(-kq, 6.12323399573676603587e-17, r);
    const int q = (int)kq & 3;
    const float rf = (float)r, r2 = rf * rf;
    const float sp = rf + rf * r2 * (-1.6666667163e-01f + r2 * (8.3333337680e-03f + r2 * (-1.9841270114e-04f + r2 * 2.7557314297e-06f)));
    const float cp = 1.0f + r2 * (-0.5f + r2 * (4.1666667908e-02f + r2 * (-1.3888889225e-03f + r2 * (2.4801587642e-05f + r2 * (-2.7557314297e-07f)))));
    s = (q == 0) ? sp : (q == 1) ? cp : (q == 2) ? -sp : -cp;
    c = (q == 0) ? cp : (q == 1) ? -sp : (q == 2) ? -cp : sp;
}
__device__ __forceinline__ void phase0(const Params& P, LAS unsigned char* lds, int G, int wave) {
    const int tid = fresh_tid(wave), lane = tid & 63;
    unsigned char* ws = P.ws;
    LAS float* scr = (LAS float*)(lds + wave * 16384);
    const int gw = blockIdx.x * NWAVES + wave, ngw = G * NWAVES;
    constexpr int I_IN = (D / 64) * (INW / 32), I_OUT = (D / 64) * (D / 32), I_UP = (D / 64) * (FF / 32), I_DN = (FF / 64) * (D / 32), I_L = I_IN + I_OUT + I_UP + I_DN;
    for (int it = gw; it < 2 * I_L; it += ngw) {
        const int l = it / I_L; int r = it - l * I_L;
        unsigned char* wl = ws + WS_W + (size_t)l * W_LAYER;
        if (r < I_IN) { const int nb = INW / 32, kb = r / nb, n = r - kb * nb; p0_transpose_item<true>(P.w_in + (size_t)l * D * INW, P.mix_pre_g + l * D, D, INW, (bf16*)wl, scr, 64 * kb, 32 * n, lane); continue; }
        r -= I_IN;
        if (r < I_OUT) { const int nb = D / 32, kb = r / nb, n = r - kb * nb; const int k0 = 64 * kb;
            const float* g = (k0 < 512) ? (P.attn_out_g + l * 512) : (P.conv_out_g + l * 512 - 512);
            p0_transpose_item<false>(P.w_out + (size_t)l * D * D, g, D, D, (bf16*)(wl + W_IN_B), scr, k0, 32 * n, lane); continue; }
        r -= I_OUT;
        if (r < I_UP) { const int nb = FF / 32, kb = r / nb, n = r - kb * nb; p0_transpose_item<false>(P.w_up + (size_t)l * D * FF, P.mlp_pre_g + l * D, D, FF, (bf16*)(wl + W_IN_B + W_OUT_B), scr, 64 * kb, 32 * n, lane); continue; }
        r -= I_UP;
        { const int nb = D / 32, kb = r / nb, n = r - kb * nb; p0_transpose_item<false>(P.w_down + (size_t)l * FF * D, nullptr, FF, D, (bf16*)(wl + W_IN_B + W_OUT_B + W_UP_B), scr, 64 * kb, 32 * n, lane); }
    }
    bf16* HB = (bf16*)(ws + WS_HB); float* PART = (float*)(ws + WS_PART);
    {
        int m0 = gw;
        for (; m0 + 3 * ngw < M_MAIN; m0 += 4 * ngw) {
            f32x4 v[4][4];
#pragma unroll
            for (int u = 0; u < 4; ++u) { const f32x4* xr = (const f32x4*)(P.x + (size_t)(m0 + u * ngw) * D) + 2 * lane;
#pragma unroll
                for (int j = 0; j < 4; ++j) v[u][j] = __builtin_nontemporal_load(&xr[128 * (j >> 1) + (j & 1)]); }
#pragma unroll
            for (int u = 0; u < 4; ++u) { const int m = m0 + u * ngw; float ss = 0.f;
#pragma unroll
                for (int j = 0; j < 4; ++j) ss += (v[u][j].x * v[u][j].x + v[u][j].y * v[u][j].y) + (v[u][j].z * v[u][j].z + v[u][j].w * v[u][j].w);
                ss = wave_sum(ss);
                u32x4* o16 = (u32x4*)(HB + (size_t)m * D) + lane;
#pragma unroll
                for (int jj = 0; jj < 2; ++jj) { u32x4 o; o.x = pk2(v[u][2 * jj].x, v[u][2 * jj].y); o.y = pk2(v[u][2 * jj].z, v[u][2 * jj].w); o.z = pk2(v[u][2 * jj + 1].x, v[u][2 * jj + 1].y); o.w = pk2(v[u][2 * jj + 1].z, v[u][2 * jj + 1].w); o16[64 * jj] = o; }
                if (lane < 16) PART[(size_t)m * 16 + lane] = (lane == 0) ? ss : 0.f; }
        }
        for (int m = m0; m < M_REAL; m += ngw) {
            const float* src = (m < M_MAIN) ? (P.x + (size_t)m * D) : (P.meta + (size_t)(m - META0) * D);
            const f32x4* xr = (const f32x4*)src + 2 * lane;
            f32x4 v[4]; float ss = 0.f;
#pragma unroll
            for (int j = 0; j < 4; ++j) { v[j] = xr[128 * (j >> 1) + (j & 1)]; ss += (v[j].x * v[j].x + v[j].y * v[j].y) + (v[j].z * v[j].z + v[j].w * v[j].w); }
            ss = wave_sum(ss);
            u32x4* o16 = (u32x4*)(HB + (size_t)m * D) + lane;
#pragma unroll
            for (int jj = 0; jj < 2; ++jj) { u32x4 o; o.x = pk2(v[2 * jj].x, v[2 * jj].y); o.y = pk2(v[2 * jj].z, v[2 * jj].w); o.z = pk2(v[2 * jj + 1].x, v[2 * jj + 1].y); o.w = pk2(v[2 * jj + 1].z, v[2 * jj + 1].w); o16[64 * jj] = o; }
            if (lane < 16) PART[(size_t)m * 16 + lane] = (lane == 0) ? ss : 0.f;
        }
    }
    float* rope = (float*)(ws + WS_ROPE);
    for (int i = blockIdx.x * NTHREADS + tid; i < LPOS * 8; i += G * NTHREADS) {
        const int pos = i >> 3, f = i & 7;
        const float ang = (float)pos * P.inv_freq[f];
        float s, c; sincos_acc(ang, s, c);
        *(f32x2*)(rope + (size_t)i * 2) = (f32x2){c, s};
    }
}

__device__ __forceinline__ void meta_thin(const Params& P, int wave, const float* g) {
    const int lane = fresh_tid(wave) & 63;
    unsigned char* ws = P.ws;
    bf16* HB = (bf16*)(ws + WS_HB); const bf16* Z = (const bf16*)(ws + WS_Z); float* PART = (float*)(ws + WS_PART);
    f32x4 gv[2][2];
#pragma unroll
    for (int jj = 0; jj < 2; ++jj) { gv[jj][0] = *(const f32x4*)(g + 8 * lane + 512 * jj); gv[jj][1] = *(const f32x4*)(g + 8 * lane + 512 * jj + 4); }
#pragma unroll
    for (int i = 0; i < 2; ++i) {
        const int m = META0 + 2 * wave + i;
        const u32x4* hp = (const u32x4*)(HB + (size_t)m * D) + lane; const u32x4* zp = (const u32x4*)(Z + (size_t)m * D) + lane;
        u32x4 hv[2], zv[2];
        hv[0] = hp[0]; hv[1] = hp[64]; zv[0] = zp[0]; zv[1] = zp[64];
        float pp = PART[(size_t)m * 16 + (lane & 15)];
        pp += __shfl_xor(pp, 1); pp += __shfl_xor(pp, 2); pp += __shfl_xor(pp, 4); pp += __shfl_xor(pp, 8);
        const float rs = rsqrtf(pp * (1.f / D) + EPS);
        float o[2][8]; float ss = 0.f;
#pragma unroll
        for (int jj = 0; jj < 2; ++jj)
#pragma unroll
            for (int q = 0; q < 4; ++q) {
                const float h0 = bflo(hv[jj][q]), h1 = bfhi(hv[jj][q]), z0 = bflo(zv[jj][q]), z1 = bfhi(zv[jj][q]);
                const float a = h0 + z0 * rs * gv[jj][q >> 1][(q & 1) * 2], b = h1 + z1 * rs * gv[jj][q >> 1][(q & 1) * 2 + 1];
                o[jj][2 * q] = a; o[jj][2 * q + 1] = b; ss += a * a + b * b;
            }
        ss = wave_sum(ss);
        u32x4* op = (u32x4*)(HB + (size_t)m * D) + lane;
#pragma unroll
        for (int jj = 0; jj < 2; ++jj) { u32x4 w; w.x = pk2(o[jj][0], o[jj][1]); w.y = pk2(o[jj][2], o[jj][3]); w.z = pk2(o[jj][4], o[jj][5]); w.w = pk2(o[jj][6], o[jj][7]); op[64 * jj] = w; }
        if (lane < 16) PART[(size_t)m * 16 + lane] = (lane == 0) ? ss : 0.f;
    }
}
__device__ __forceinline__ void hand_post(unsigned* word, int wave) {
    const int tid = fresh_tid(wave);
    asm volatile("s_waitcnt vmcnt(0)" ::: "memory"); __syncthreads();
    if (tid == 0) { __builtin_amdgcn_fence(__ATOMIC_RELEASE, "agent"); asm volatile("s_waitcnt vmcnt(0)" ::: "memory"); __hip_atomic_fetch_add(word, 1u, __ATOMIC_RELAXED, __HIP_MEMORY_SCOPE_AGENT); }
}
__device__ __forceinline__ void hand_wait(unsigned* word, unsigned need, int wave) {
    const int tid = fresh_tid(wave);
    if (tid == 0) { unsigned sp = 0; while (__hip_atomic_load(word, __ATOMIC_RELAXED, __HIP_MEMORY_SCOPE_AGENT) < need && ++sp < (1u << 22)) __builtin_amdgcn_s_sleep(2);
                    __builtin_amdgcn_fence(__ATOMIC_ACQUIRE, "agent"); asm volatile("s_waitcnt vmcnt(0)" ::: "memory"); }
    __syncthreads();
}

__device__ __forceinline__ int slot_row(bool ismeta, int j, int mq0, int slot) {
    if (ismeta) return (slot >= 128 && slot < 128 + NMETA) ? META0 + slot - 128 : -1;
    if (slot >= 128) return mq0 + slot - 128;
    if (j > 0) return mq0 - 128 + slot;
    return slot >= 128 - NMETA ? META0 + slot - (128 - NMETA) : -1;
}
#define MFMA32(a, b, c) __builtin_amdgcn_mfma_f32_32x32x16_bf16((a), (b), (c), 0, 0, 0)
template <int NROWS>
__device__ __forceinline__ void conv_rows(const bf16* PROJ, bf16* Y, const float* cw, int lane, int mfirst, int p1, int p2) {
    const int c0 = 8 * lane;
    float w0[8], w1[8], w2[8], u1[8], u2[8];
#pragma unroll
    for (int e = 0; e < 8; ++e) { w0[e] = cw[c0 + e]; w1[e] = cw[512 + c0 + e]; w2[e] = cw[1024 + c0 + e]; u1[e] = 0.f; u2[e] = 0.f; }
    if (p1 >= 0) { const u32x4 uv = *(const u32x4*)(PROJ + (size_t)p1 * PW + C_U + c0);
#pragma unroll
        for (int q = 0; q < 4; ++q) { u1[2 * q] = bflo(uv[q]); u1[2 * q + 1] = bfhi(uv[q]); } }
    if (p2 >= 0) { const u32x4 uv = *(const u32x4*)(PROJ + (size_t)p2 * PW + C_U + c0);
#pragma unroll
        for (int q = 0; q < 4; ++q) { u2[2 * q] = bflo(uv[q]); u2[2 * q + 1] = bfhi(uv[q]); } }
#pragma unroll 8
    for (int i = 0; i < NROWS; ++i) {
        const size_t m = (size_t)(mfirst + i);
        const u32x4 bv = *(const u32x4*)(PROJ + m * PW + C_B + c0), uv = *(const u32x4*)(PROJ + m * PW + C_U + c0);
        float y[8], u0[8]; float ss = 0.f;
#pragma unroll
        for (int q = 0; q < 4; ++q) {
            u0[2 * q] = bflo(uv[q]); u0[2 * q + 1] = bfhi(uv[q]);
            y[2 * q] = bflo(bv[q]) * (w0[2 * q] * u2[2 * q] + w1[2 * q] * u1[2 * q] + w2[2 * q] * u0[2 * q]);
            y[2 * q + 1] = bfhi(bv[q]) * (w0[2 * q + 1] * u2[2 * q + 1] + w1[2 * q + 1] * u1[2 * q + 1] + w2[2 * q + 1] * u0[2 * q + 1]);
            ss += y[2 * q] * y[2 * q] + y[2 * q + 1] * y[2 * q + 1];
        }
        ss = wave_sum(ss);
        const float rs = rsqrtf(ss * (1.f / 512.f) + EPS);
        u32x4 w; w.x = pk2(y[0] * rs, y[1] * rs); w.y = pk2(y[2] * rs, y[3] * rs); w.z = pk2(y[4] * rs, y[5] * rs); w.w = pk2(y[6] * rs, y[7] * rs);
        *(u32x4*)(Y + m * D + 512 + c0) = w;
#pragma unroll
        for (int e = 0; e < 8; ++e) { u2[e] = u1[e]; u1[e] = u0[e]; }
    }
}
__device__ __forceinline__ float mask_sel(int m, float v) { return __builtin_bit_cast(float, (__builtin_bit_cast(int, v) & m) | (int)(0xff800000u & ~(unsigned)m)); }
#define MASK_TILE(S, TT) do { \
    if ((TT) == 0) { _Pragma("unroll") for (int e = 0; e < 16; ++e) { const int ce = (e & 3) + 8 * (e >> 2); S[e] = mask_sel((d0 - ce) >> 31, S[e]); } } \
    if ((TT) == 4) { _Pragma("unroll") for (int e = 0; e < 16; ++e) { const int ce = (e & 3) + 8 * (e >> 2); S[e] = mask_sel((ce - d0 - 1) >> 31, S[e]); } } \
    if (lo > 0) { _Pragma("unroll") for (int e = 0; e < 16; ++e) { const int ce = (e & 3) + 8 * (e >> 2); S[e] = mask_sel((lo - 1 - (32 * (sb + (TT)) + 4 * hh + ce)) >> 31, S[e]); } } \
  } while (0)
__device__ __forceinline__ void mixer_unit(const Params& P, LAS unsigned char* lds, int unit, int layer, int wave) {
    const int tid = fresh_tid(wave), lane = tid & 63;
    unsigned char* ws = P.ws;
    const bf16* PROJ = (const bf16*)(ws + WS_PROJ); bf16* Y = (bf16*)(ws + WS_Y);
    const bool ismeta = (unit == 256);
    const int b = unit >> 6, j = unit & 63;
    const int mq0 = ismeta ? META0 : (b * SEQ + 128 * j);
    const int lo = ismeta ? 128 : (j == 0 ? 128 - NMETA : 0);
    const int h = wave, hk = h >> 2, r = lane & 31, hh = lane >> 5;
    bf16x8 qn[4];
    { const bf16* qp = PROJ + (size_t)(mq0 + r) * PW + h * 64 + 8 * hh;
#pragma unroll
      for (int ks = 0; ks < 4; ++ks) qn[ks] = *(const bf16x8*)(qp + 16 * ks); }
    {
    __syncthreads();
#pragma unroll
    for (int it = 0; it < 8; ++it) {
        const int q = tid + NTHREADS * it, slot = q >> 4, c = q & 15; const int row = slot_row(ismeta, j, mq0, slot);
        u32x4 v = (u32x4){0u, 0u, 0u, 0u}; if (row >= 0) v = *(const u32x4*)(PROJ + (size_t)row * PW + C_K + c * 8);
        *(LAS u32x4*)(lds + KL_OFF + (((c >> 3) * 256 + slot) * KL_ROW + (c & 7) * 8) * 2) = v;
    }
#pragma unroll
    for (int it = 0; it < 4; ++it) {
        const int w = tid + NTHREADS * it, sp = w & 127, c = w >> 7; const int r0 = slot_row(ismeta, j, mq0, 2 * sp), r1 = slot_row(ismeta, j, mq0, 2 * sp + 1);
        u32x4 a = (u32x4){0u, 0u, 0u, 0u}, bq = (u32x4){0u, 0u, 0u, 0u};
        if (r0 >= 0) a = *(const u32x4*)(PROJ + (size_t)r0 * PW + C_V + c * 8);
        if (r1 >= 0) bq = *(const u32x4*)(PROJ + (size_t)r1 * PW + C_V + c * 8);
        const int hk = c >> 3, d0 = (c & 7) * 8;
#pragma unroll
        for (int e = 0; e < 8; ++e) {
            const unsigned l16 = (a[e >> 1] >> (16 * (e & 1))) & 0xffffu, h16 = (bq[e >> 1] >> (16 * (e & 1))) & 0xffffu;
            *(LAS unsigned*)(lds + VT_OFF + ((hk * 64 + d0 + e) * VT_ROW + 2 * sp) * 2) = l16 | (h16 << 16);
        }
    }
    __syncthreads();
    }
    const float sink2 = P.sinks[layer * 8 + h] * LOG2E;
    LAS float* SS = (LAS float*)(lds + SS_OFF);
    const int nsb = ismeta ? 1 : 4;
    const float* cw = P.conv_w + (size_t)layer * 3 * 512;
    const int c0 = 8 * lane, cfirst = mq0 + 16 * wave;
    float cu1[8], cu2[8];
#pragma unroll
    for (int e = 0; e < 8; ++e) { cu1[e] = 0.f; cu2[e] = 0.f; }
    if (!ismeta) {
        const int s0 = cfirst & (SEQ - 1);
        const int p1 = (s0 == 0) ? META0 + 15 : cfirst - 1, p2 = (s0 == 0) ? META0 + 14 : cfirst - 2;
        const u32x4 a1 = *(const u32x4*)(PROJ + (size_t)p1 * PW + C_U + c0), a2 = *(const u32x4*)(PROJ + (size_t)p2 * PW + C_U + c0);
#pragma unroll
        for (int q = 0; q < 4; ++q) { cu1[2 * q] = bflo(a1[q]); cu1[2 * q + 1] = bfhi(a1[q]); cu2[2 * q] = bflo(a2[q]); cu2[2 * q + 1] = bfhi(a2[q]); }
    }
#pragma nounroll
    for (int sb = 0; sb < nsb; ++sb) {
        u32x4 cbv[4], cuv[4];
        if (!ismeta) {
#pragma unroll
            for (int i = 0; i < 4; ++i) { const size_t m = (size_t)(cfirst + 4 * sb + i); cbv[i] = __builtin_nontemporal_load((const u32x4*)(PROJ + m * PW + C_B + c0)); cuv[i] = __builtin_nontemporal_load((const u32x4*)(PROJ + m * PW + C_U + c0)); }
        }
        int rr = r; asm volatile("" : "+v"(rr));
        const int d0 = rr - 4 * hh;
        bf16x8 qf[4];
#pragma unroll
        for (int ks = 0; ks < 4; ++ks) qf[ks] = qn[ks];
        if (sb + 1 < nsb) { const bf16* qp = PROJ + (size_t)(mq0 + 32 * (sb + 1) + r) * PW + h * 64 + 8 * hh;
#pragma unroll
            for (int ks = 0; ks < 4; ++ks) qn[ks] = *(const bf16x8*)(qp + 16 * ks); }
        const LAS unsigned char* kbase = lds + KL_OFF + ((hk * 256 + 32 * sb + r) * KL_ROW + 8 * hh) * 2;
        const LAS unsigned char* vbase = lds + VT_OFF + ((hk * 64 + r) * VT_ROW + 32 * sb + 4 * hh) * 2;
        f32x16 s[5];
#pragma unroll
        for (int tt = 0; tt < 5; ++tt) {
#pragma unroll
            for (int e = 0; e < 16; ++e) s[tt][e] = 0.f;
#pragma unroll
            for (int ks = 0; ks < 4; ++ks) { const bf16x8 kf = *(const LAS bf16x8*)(kbase + tt * (32 * KL_ROW * 2) + 32 * ks); s[tt] = MFMA32(kf, qf[ks], s[tt]); }
        }
#pragma unroll
        for (int tt = 0; tt < 5; ++tt) MASK_TILE(s[tt], tt);
        float mx = sink2;
#pragma unroll
        for (int tt = 0; tt < 5; ++tt)
#pragma unroll
            for (int e = 0; e < 16; ++e) mx = fmaxf(mx, s[tt][e]);
        mx = fmaxf(mx, __shfl_xor(mx, 32));
        float sum = 0.f;
        f32x16 o[2];
#pragma unroll
        for (int e = 0; e < 16; ++e) { o[0][e] = 0.f; o[1][e] = 0.f; }
#pragma unroll
        for (int tt = 0; tt < 5; ++tt) {
#pragma unroll
            for (int e = 0; e < 16; ++e) { const float ev = __builtin_amdgcn_exp2f(s[tt][e] - mx); s[tt][e] = ev; sum += ev; }
#pragma unroll
            for (int st = 0; st < 2; ++st) {
                u32x4 pw; pw.x = pk2(s[tt][8 * st + 0], s[tt][8 * st + 1]); pw.y = pk2(s[tt][8 * st + 2], s[tt][8 * st + 3]); pw.z = pk2(s[tt][8 * st + 4], s[tt][8 * st + 5]); pw.w = pk2(s[tt][8 * st + 6], s[tt][8 * st + 7]);
                const bf16x8 pf = __builtin_bit_cast(bf16x8, pw);
#pragma unroll
                for (int dh = 0; dh < 2; ++dh) {
                    const LAS unsigned char* vb = vbase + dh * (32 * VT_ROW * 2) + (32 * tt + 16 * st) * 2;
                    const u32x2 v0 = *(const LAS u32x2*)vb, v1 = *(const LAS u32x2*)(vb + 16);
                    const bf16x8 vf = __builtin_bit_cast(bf16x8, (u32x4){v0.x, v0.y, v1.x, v1.y});
                    o[dh] = MFMA32(vf, pf, o[dh]);
                }
            }
        }
        sum += __shfl_xor(sum, 32);
        const float inv = 1.0f / (sum + __builtin_amdgcn_exp2f(sink2 - mx));
        float ssq = 0.f;
#pragma unroll
        for (int dh = 0; dh < 2; ++dh)
#pragma unroll
            for (int e = 0; e < 16; ++e) { const float a = o[dh][e] * inv; o[dh][e] = a; ssq += a * a; }
        ssq += __shfl_xor(ssq, 32);
        LAS float* ssp = SS + (sb & 1) * 256;
        if (hh == 0) ssp[h * 32 + r] = ssq;
        asm volatile("s_waitcnt lgkmcnt(0)" ::: "memory"); __builtin_amdgcn_s_barrier(); asm volatile("" ::: "memory");
        float tot = 0.f;
#pragma unroll
        for (int h2 = 0; h2 < 8; ++h2) tot += ssp[h2 * 32 + r];
        const float rsn = rsqrtf(tot * (1.f / 512.f) + EPS);
        bf16* yp = Y + (size_t)(mq0 + 32 * sb + r) * D + h * 64 + 8 * hh;
        const bool st_ok = !ismeta || r < NMETA;
#pragma unroll
        for (int kp = 0; kp < 4; ++kp) {
            const int dh = kp >> 1, g4 = 2 * (kp & 1);
            unsigned ax = pk2(o[dh][4 * g4] * rsn, o[dh][4 * g4 + 1] * rsn), ay = pk2(o[dh][4 * g4 + 2] * rsn, o[dh][4 * g4 + 3] * rsn);
            unsigned bx = pk2(o[dh][4 * g4 + 4] * rsn, o[dh][4 * g4 + 5] * rsn), by = pk2(o[dh][4 * g4 + 6] * rsn, o[dh][4 * g4 + 7] * rsn);
            { const auto rx = __builtin_amdgcn_permlane32_swap(ax, bx, false, false); ax = rx[0]; bx = rx[1]; }
            { const auto ry = __builtin_amdgcn_permlane32_swap(ay, by, false, false); ay = ry[0]; by = ry[1]; }
            if (st_ok) *(u32x4*)(yp + 16 * kp) = (u32x4){ax, ay, bx, by};
        }
        if (!ismeta) {
            float w0[8], w1[8], w2[8];
#pragma unroll
            for (int e = 0; e < 8; ++e) { w0[e] = cw[c0 + e]; w1[e] = cw[512 + c0 + e]; w2[e] = cw[1024 + c0 + e]; }
#pragma unroll
            for (int i = 0; i < 4; ++i) {
                float y[8], u0[8]; float ss = 0.f;
#pragma unroll
                for (int q = 0; q < 4; ++q) {
                    u0[2 * q] = bflo(cuv[i][q]); u0[2 * q + 1] = bfhi(cuv[i][q]);
                    y[2 * q] = bflo(cbv[i][q]) * (w0[2 * q] * cu2[2 * q] + w1[2 * q] * cu1[2 * q] + w2[2 * q] * u0[2 * q]);
                    y[2 * q + 1] = bfhi(cbv[i][q]) * (w0[2 * q + 1] * cu2[2 * q + 1] + w1[2 * q + 1] * cu1[2 * q + 1] + w2[2 * q + 1] * u0[2 * q + 1]);
                    ss += y[2 * q] * y[2 * q] + y[2 * q + 1] * y[2 * q + 1];
                }
                ss = wave_sum(ss);
                const float rsc = rsqrtf(ss * (1.f / 512.f) + EPS);
                u32x4 w; w.x = pk2(y[0] * rsc, y[1] * rsc); w.y = pk2(y[2] * rsc, y[3] * rsc); w.z = pk2(y[4] * rsc, y[5] * rsc); w.w = pk2(y[6] * rsc, y[7] * rsc);
                *(u32x4*)(Y + (size_t)(cfirst + 4 * sb + i) * D + 512 + c0) = w;
#pragma unroll
                for (int e = 0; e < 8; ++e) { cu2[e] = cu1[e]; cu1[e] = u0[e]; }
            }
        }
    }
    if (ismeta) {
        const int i0 = 2 * wave;
        conv_rows<2>(PROJ, Y, cw, lane, META0 + i0, i0 >= 1 ? META0 + i0 - 1 : -1, i0 >= 2 ? META0 + i0 - 2 : -1);
    }
}

#ifndef WGM_IN
#define WGM_IN 4
#endif
#ifndef WGM_UP
#define WGM_UP 4
#endif
#ifndef WGM_RES
#define WGM_RES 4
#endif
__global__ void __launch_bounds__(NTHREADS, 2) hymba_fwd(Params P) {
    extern __shared__ __attribute__((aligned(16))) unsigned char lds_raw[];
    LAS unsigned char* lds = (LAS unsigned char*)lds_raw;
    volatile LAS unsigned* MISC = (volatile LAS unsigned*)(lds + MISC_OFF);
    const int wave = __builtin_amdgcn_readfirstlane((int)threadIdx.x >> 6);
    const int G = gridDim.x;
    unsigned char* ws = P.ws;
    { const int t0 = fresh_tid(wave); if (t0 < 32) MISC[t0] = 0u; }
    __syncthreads();
    XcdBarrier bar = xcd_barrier_post((unsigned*)(ws + WS_CTL) + CW_BAR, MISC + 8, wave);

    {
    phase0(P, lds, G, wave);
    cg::this_grid().sync();
    }

    bf16* HB = (bf16*)(ws + WS_HB); bf16* Z = (bf16*)(ws + WS_Z); bf16* U = (bf16*)(ws + WS_U); bf16* PROJ = (bf16*)(ws + WS_PROJ); bf16* Y = (bf16*)(ws + WS_Y);
    float* PART = (float*)(ws + WS_PART); const float* rope = (const float*)(ws + WS_ROPE);
    unsigned* ctl = (unsigned*)(ws + WS_CTL);
#pragma unroll
    for (int l = 0; l < 2; ++l) {
        const unsigned char* wl = ws + WS_W + (size_t)l * W_LAYER;
        const bf16* W_IN = (const bf16*)wl; const bf16* W_OUT = (const bf16*)(wl + W_IN_B); const bf16* W_UP = (const bf16*)(wl + W_IN_B + W_OUT_B); const bf16* W_DN = (const bf16*)(wl + W_IN_B + W_OUT_B + W_UP_B);
        {
        if (l == 1 && blockIdx.x == 0) { meta_thin(P, wave, P.mlp_post_g); hand_post(ctl + CW_T + 64, wave); }
        { pg8::Gemm g{HB, W_IN, M_MAIN, INW, D}; pg8::StaticOrder S; S.init(M_MAIN, INW, G, (int)blockIdx.x, WGM_IN); EpiIn E{PROJ, PART, rope};
          pg8::gemm_phase<EpiIn, pg8::StaticOrder, true, true>(lds, g, S, E, wave); }
        { const int mb = (int)blockIdx.x - (G - 1 - INW / 64);
          unsigned* mcnt = ctl + CW_META + 64 * l;
          if (mb >= 0 && mb < INW / 64) {
              if (l == 1) hand_wait(ctl + CW_T + 64, 1u, wave);
              meta_gemm<0>(lds, HB + (size_t)META0 * D, W_IN, D, mb, PROJ, PART, rope, wave);
              if (l == 0) hand_post(mcnt, wave);
          }
          if (l == 0 && (int)blockIdx.x == G - 1) { hand_wait(mcnt, (unsigned)(INW / 64), wave); mixer_unit(P, lds, 256, l, wave); }
        }
        xcd_barrier(bar);
        }
        {
        for (int unit = blockIdx.x; unit < 256; unit += G) mixer_unit(P, lds, unit, l, wave);
        xcd_barrier(bar);
        }
        { pg8::Gemm g{Y, W_OUT, M_MAIN, D, D}; pg8::StaticOrder S; S.init(M_MAIN, D, G, (int)blockIdx.x, WGM_RES);
          EpiRes<false> E{HB, nullptr, P.mix_post_g + l * D, (float*)(ws + WS_PARTB), (float*)(ws + WS_X) + (size_t)(2 * l) * 131072, ctl + CW_X + (2 * l) * 8192, lds, nullptr};
          pg8::gemm_phase<EpiRes<false>, pg8::StaticOrder, true, true>(lds, g, S, E, wave); }
        if (l == 0 && (int)blockIdx.x < D / 64) meta_gemm<1>(lds, Y + (size_t)META0 * D, W_OUT, D, (int)blockIdx.x, Z, PART, rope, wave);
        xcd_barrier(bar);
        {
        if (l == 0 && blockIdx.x == 0) { meta_thin(P, wave, P.mix_post_g); hand_post(ctl + CW_T, wave); }
        { pg8::Gemm g{HB, W_UP, M_MAIN, FF, D}; pg8::StaticOrder S; S.init(M_MAIN, FF, G, (int)blockIdx.x, WGM_UP); EpiUp E{U};
          pg8::gemm_phase<EpiUp, pg8::StaticOrder, true, true>(lds, g, S, E, wave); }
        if (l == 0 && (int)blockIdx.x < FF / 64) { hand_wait(ctl + CW_T, 1u, wave); meta_gemm<2>(lds, HB + (size_t)META0 * D, W_UP, D, (int)blockIdx.x, U, PART, rope, wave); }
        xcd_barrier(bar);
        }
        if (l == 0) {
            { pg8::Gemm g{U, W_DN, M_MAIN, D, FF}; pg8::StaticOrder S; S.init(M_MAIN, D, G, (int)blockIdx.x, WGM_RES);
              EpiRes<false> E{HB, nullptr, P.mlp_post_g, PART, (float*)(ws + WS_X) + (size_t)1 * 131072, ctl + CW_X + 1 * 8192, lds, (const float*)(ws + WS_PARTB)};
              pg8::gemm_phase<EpiRes<false>, pg8::StaticOrder, true, true, true>(lds, g, S, E, wave); }
            if ((int)blockIdx.x < D / 64) meta_gemm<1>(lds, U + (size_t)META0 * FF, W_DN, FF, (int)blockIdx.x, Z, PART, rope, wave);
            xcd_barrier(bar);
        } else {
            pg8::Gemm g{U, W_DN, M_MAIN, D, FF}; pg8::StaticOrder S; S.init(M_MAIN, D, G, (int)blockIdx.x, WGM_RES);
            EpiRes<true> E{HB, P.out, P.mlp_post_g + D, PART, (float*)(ws + WS_X) + (size_t)3 * 131072, ctl + CW_X + 3 * 8192, lds, (const float*)(ws + WS_PARTB)};
            pg8::gemm_phase<EpiRes<true>, pg8::StaticOrder, true, true, true>(lds, g, S, E, wave);
        }
    }
}

extern "C" void kernel_launch(void* const* d_in, const int* in_sizes, int n_in, void* d_out, int out_size, void* d_ws, size_t ws_size, hipStream_t stream) {
    static int grid = 0;
    if (grid == 0) {
        if (n_in != 14 || in_sizes[0] != M_MAIN * D || out_size != M_MAIN * D || ws_size < WS_END) {
            fprintf(stderr, "kernel_launch: unexpected shapes (n_in %d, in0 %d, out %d, ws %zu < %zu); nothing launched\n", n_in, n_in > 0 ? in_sizes[0] : -1, out_size, ws_size, (size_t)WS_END); grid = -1; return; }
        int dev = 0, cus = 0, per_cu = 0;
        if (hipGetDevice(&dev) != hipSuccess || hipDeviceGetAttribute(&cus, hipDeviceAttributeMultiprocessorCount, dev) != hipSuccess) { fprintf(stderr, "kernel_launch: device query failed\n"); grid = -1; return; }
        if (hipFuncSetAttribute((const void*)hymba_fwd, hipFuncAttributeMaxDynamicSharedMemorySize, LDS_BYTES) != hipSuccess) { fprintf(stderr, "kernel_launch: hipFuncSetAttribute failed\n"); grid = -1; return; }
        if (hipOccupancyMaxActiveBlocksPerMultiprocessor(&per_cu, (const void*)hymba_fwd, NTHREADS, LDS_BYTES) != hipSuccess || per_cu < 1) { fprintf(stderr, "kernel_launch: occupancy query says %d\n", per_cu); per_cu = 1; }
        (void)hipGetLastError();
        if (cus != 256) { fprintf(stderr, "kernel_launch: built for a 256-CU device (fused epilogues pair four workgroups per round); found %d CUs; nothing launched\n", cus); grid = -1; return; }
        grid = cus * 1;
    }
    if (grid < 0) return;
    if (hipMemsetAsync((char*)d_ws + WS_CTL, 0, CTL_BYTES, stream) != hipSuccess) { fprintf(stderr, "kernel_launch: memset failed\n"); return; }
    Params p{};
    p.x = (const float*)d_in[0]; p.meta = (const float*)d_in[1]; p.mix_pre_g = (const float*)d_in[2]; p.w_in = (const float*)d_in[3]; p.conv_w = (const float*)d_in[4];
    p.sinks = (const float*)d_in[5]; p.attn_out_g = (const float*)d_in[6]; p.conv_out_g = (const float*)d_in[7]; p.w_out = (const float*)d_in[8]; p.mix_post_g = (const float*)d_in[9];
    p.mlp_pre_g = (const float*)d_in[10]; p.w_up = (const float*)d_in[11]; p.w_down = (const float*)d_in[12]; p.mlp_post_g = (const float*)d_in[13];
    p.out = (float*)d_out; p.ws = (unsigned char*)d_ws;
    for (int i = 0; i < 8; ++i) p.inv_freq[i] = (float)pow(500000.0, -(double)i / 8.0);
    void* args[] = {&p};
    const hipError_t e = hipLaunchCooperativeKernel((const void*)hymba_fwd, dim3(grid), dim3(NTHREADS), args, LDS_BYTES, stream);
    if (e != hipSuccess) fprintf(stderr, "kernel_launch: cooperative launch failed: %s (grid %d)\n", hipGetErrorString(e), grid);
}
```
